# Optimizing an MI355X kernel written in HIP

```python
import math
import jax, jax.numpy as jnp
from jax import lax
import numpy as np

D_MODEL = 2048
BATCH = 4
SEQ = 4096
DEPTH = 1
DEC_BATCH = 4
DEC_SEQ = 2048
PAST_LEN = 128

MIX_WIDTH = D_MODEL
HEAD_DIM = 128
DIFF_WIDTH = MIX_WIDTH // 2
RET_WIDTH = MIX_WIDTH - DIFF_WIDTH
H_DIFF = DIFF_WIDTH // HEAD_DIM
H_RET = RET_WIDTH // HEAD_DIM
DIFF_QK_DIM = HEAD_DIM // 2
D_FF = ((8 * D_MODEL // 3 + 255) // 256) * 256
IN_SIZES = (H_DIFF * 2 * DIFF_QK_DIM, H_DIFF * 2 * DIFF_QK_DIM, H_DIFF * HEAD_DIM,
            H_RET * HEAD_DIM, H_RET * HEAD_DIM, H_RET * HEAD_DIM, RET_WIDTH)
IN_WIDTH = sum(IN_SIZES)
N_BUCKETS = 32
REL_MAX_DIST = 128
Q_BLOCK = 128
RET_CHUNK = 128
ROPE_BASE = 10000.0
N_MOD = 9
EPS = 1e-6

kernel_name = "hybrid_diffattn_retention_macaron_encoder"


def _rms(x, g):
    xf = x.astype(jnp.float32)
    y = xf * lax.rsqrt(jnp.mean(xf * xf, axis=-1, keepdims=True) + EPS)
    return (y * g.astype(jnp.float32)).astype(x.dtype)


def _modulate(h, shift, scale):
    return h * (1.0 + scale[:, None, :]) + shift[:, None, :]


def _swiglu(h, w13, w2):
    a = h @ w13
    gate, up = jnp.split(a, 2, axis=-1)
    return (jax.nn.silu(gate) * up) @ w2


def _t5_bucket(rel):
    half = N_BUCKETS // 2
    max_exact = half // 2
    ret = jnp.where(rel > 0, half, 0)
    n = jnp.abs(rel)
    nf = jnp.maximum(n, 1).astype(jnp.float32)
    large = max_exact + (jnp.log(nf / max_exact) / math.log(REL_MAX_DIST / max_exact)
                         * (half - max_exact)).astype(jnp.int32)
    large = jnp.minimum(large, half - 1)
    return ret + jnp.where(n < max_exact, n, large)


def _rotary(x, pos):
    d = x.shape[-1]
    inv = ROPE_BASE ** (-jnp.arange(0, d, 2, dtype=jnp.float32) / d)
    ang = pos[:, None] * inv[None, :]
    cos = jnp.cos(ang)[None, :, None, :]
    sin = jnp.sin(ang)[None, :, None, :]
    x1, x2 = x[..., : d // 2], x[..., d // 2:]
    return jnp.concatenate([x1 * cos - x2 * sin, x1 * sin + x2 * cos], axis=-1)


def _diff_attention(q, k, v, rel_bias, lam):
    B, S, H, _, dq = q.shape
    dv = v.shape[-1]
    scale = dq ** -0.5
    k1, k2 = k[..., 0, :], k[..., 1, :]
    kpos = jnp.arange(S, dtype=jnp.int32)
    nb = S // Q_BLOCK
    qb = q.reshape(B, nb, Q_BLOCK, H, 2, dq).transpose(1, 0, 3, 2, 4, 5)
    starts = jnp.arange(nb, dtype=jnp.int32) * Q_BLOCK

    def block(args):
        qi, s0 = args
        qpos = s0 + jnp.arange(Q_BLOCK, dtype=jnp.int32)
        bucket = _t5_bucket(kpos[None, :] - qpos[:, None])
        bias = jnp.transpose(rel_bias[bucket], (2, 0, 1)).astype(jnp.float32)
        s1 = jnp.einsum('bhqd,bkhd->bhqk', qi[..., 0, :], k1).astype(jnp.float32) * scale + bias
        s2 = jnp.einsum('bhqd,bkhd->bhqk', qi[..., 1, :], k2).astype(jnp.float32) * scale + bias
        p = jax.nn.softmax(s1, axis=-1) - lam * jax.nn.softmax(s2, axis=-1)
        return jnp.einsum('bhqk,bkhv->bqhv', p.astype(v.dtype), v)

    out = lax.map(block, (qb, starts))
    return out.transpose(1, 0, 2, 3, 4).reshape(B, S, H, dv)


def _retention_dir(q, k, v, log_gamma, include_diag):
    B, S, H, d = q.shape
    dv = v.shape[-1]
    C = RET_CHUNK
    n = S // C

    def chunks(t):
        return t.reshape(B, n, C, H, t.shape[-1]).transpose(1, 0, 3, 2, 4)

    idx = jnp.arange(C, dtype=jnp.float32)
    diff = idx[:, None] - idx[None, :]
    mask = (diff >= 0) if include_diag else (diff > 0)
    decay = jnp.where(mask[None], jnp.exp(log_gamma[:, None, None] * jnp.maximum(diff, 0.0)[None]), 0.0)
    xi = jnp.exp(log_gamma[:, None] * (idx + 1.0)[None])[..., None]
    zeta = jnp.exp(log_gamma[:, None] * (C - 1.0 - idx)[None])[..., None]
    g_c = jnp.exp(log_gamma * C)[:, None, None]

    def step(R, qkv):
        qc, kc, vc = qkv
        inner = jnp.einsum('bhnd,bhmd->bhnm', qc, kc) * decay
        o = jnp.einsum('bhnm,bhmv->bhnv', inner, vc) + jnp.einsum('bhnd,bhdv->bhnv', qc * xi, R)
        R = g_c * R + jnp.einsum('bhmd,bhmv->bhdv', kc * zeta, vc)
        return R, o

    R0 = jnp.zeros((B, H, d, dv), jnp.float32)
    _, o = lax.scan(step, R0, (chunks(q), chunks(k), chunks(v)))
    return o.transpose(1, 0, 3, 2, 4).reshape(B, S, H, dv)


def _mixer(h, layer_idx, w_in, lq1, lk1, lq2, lk2, diff_head_g, rel_bias,
           decay_f, decay_b, ret_head_g, w_out):
    B, S, _ = h.shape
    proj = h @ w_in
    split_pts = [int(p) for p in np.cumsum(IN_SIZES)[:-1]]
    dq, dk, dv, rq, rk, rv, rg = jnp.split(proj, split_pts, axis=-1)

    dq = dq.reshape(B, S, H_DIFF, 2, DIFF_QK_DIM)
    dk = dk.reshape(B, S, H_DIFF, 2, DIFF_QK_DIM)
    dv = dv.reshape(B, S, H_DIFF, HEAD_DIM)
    lam_init = 0.8 - 0.6 * math.exp(-0.3 * layer_idx)
    lam = (jnp.exp(jnp.sum(lq1.astype(jnp.float32) * lk1.astype(jnp.float32)))
           - jnp.exp(jnp.sum(lq2.astype(jnp.float32) * lk2.astype(jnp.float32))) + lam_init)
    d_out = _diff_attention(dq, dk, dv, rel_bias, lam)
    d_out = (_rms(d_out, diff_head_g) * (1.0 - lam_init)).reshape(B, S, DIFF_WIDTH)

    pos = jnp.arange(S, dtype=jnp.float32)
    rq = _rotary(rq.reshape(B, S, H_RET, HEAD_DIM).astype(jnp.float32), pos)
    rk = _rotary(rk.reshape(B, S, H_RET, HEAD_DIM).astype(jnp.float32), pos) * (HEAD_DIM ** -0.5)
    rv = rv.reshape(B, S, H_RET, HEAD_DIM).astype(jnp.float32)
    lg_f = jax.nn.log_sigmoid(decay_f.astype(jnp.float32))
    lg_b = jax.nn.log_sigmoid(decay_b.astype(jnp.float32))
    o_f = _retention_dir(rq, rk, rv, lg_f, True)
    o_b = jnp.flip(_retention_dir(jnp.flip(rq, 1), jnp.flip(rk, 1), jnp.flip(rv, 1), lg_b, False), 1)
    r_out = _rms(o_f + o_b, ret_head_g).astype(h.dtype).reshape(B, S, RET_WIDTH) * jax.nn.silu(rg)

    return jnp.concatenate([d_out, r_out], axis=-1) @ w_out


def _trunk(x, c, ada_w, ada_b, ffn1_norm_g, ffn1_w13, ffn1_w2, mix_norm_g, w_in,
           diff_lambda_q1, diff_lambda_k1, diff_lambda_q2, diff_lambda_k2, diff_head_g,
           rel_bias, ret_decay_fwd, ret_decay_bwd, ret_head_g, w_out,
           ffn2_norm_g, ffn2_w13, ffn2_w2, final_norm_g):
    for l in range(DEPTH):
        mod = jax.nn.silu(c) @ ada_w[l] + ada_b[l]
        sh1, sc1, g1, shm, scm, gm, sh2, sc2, g2 = jnp.split(mod, N_MOD, axis=-1)
        h = _modulate(_rms(x, ffn1_norm_g[l]), sh1, sc1)
        x = x + 0.5 * g1[:, None, :] * _swiglu(h, ffn1_w13[l], ffn1_w2[l])
        h = _modulate(_rms(x, mix_norm_g[l]), shm, scm)
        x = x + gm[:, None, :] * _mixer(h, l, w_in[l], diff_lambda_q1[l], diff_lambda_k1[l],
                                         diff_lambda_q2[l], diff_lambda_k2[l], diff_head_g[l],
                                         rel_bias, ret_decay_fwd[l], ret_decay_bwd[l],
                                         ret_head_g[l], w_out[l])
        h = _modulate(_rms(x, ffn2_norm_g[l]), sh2, sc2)
        x = x + 0.5 * g2[:, None, :] * _swiglu(h, ffn2_w13[l], ffn2_w2[l])
    return _rms(x, final_norm_g)


def setup_inputs(seed: int = 0) -> dict:
    key = jax.random.key(seed)
    ks = jax.random.split(key, 26)
    f32 = jnp.float32
    nrm = lambda k, shape, s: jax.random.normal(k, shape, f32) * s
    gain = lambda k, shape: 1.0 + 0.05 * jax.random.normal(k, shape, f32)
    base_logit = jnp.log(2.0 ** (5.0 + jnp.arange(H_RET, dtype=f32)) - 1.0)
    return {
        "x_prompt": nrm(ks[0], (BATCH, SEQ, D_MODEL), 1.0),
        "x_sample": nrm(ks[1], (DEC_BATCH, DEC_SEQ, D_MODEL), 1.0),
        "c_prompt": nrm(ks[2], (BATCH, D_MODEL), 1.0),
        "c_sample": nrm(ks[3], (DEC_BATCH, D_MODEL), 1.0),
        "ada_w": nrm(ks[4], (DEPTH, D_MODEL, N_MOD * D_MODEL), D_MODEL ** -0.5),
        "ada_b": nrm(ks[5], (DEPTH, N_MOD * D_MODEL), 0.02),
        "ffn1_norm_g": gain(ks[6], (DEPTH, D_MODEL)),
        "ffn1_w13": nrm(ks[7], (DEPTH, D_MODEL, 2 * D_FF), D_MODEL ** -0.5),
        "ffn1_w2": nrm(ks[8], (DEPTH, D_FF, D_MODEL), D_FF ** -0.5),
        "mix_norm_g": gain(ks[9], (DEPTH, D_MODEL)),
        "w_in": nrm(ks[10], (DEPTH, D_MODEL, IN_WIDTH), D_MODEL ** -0.5),
        "diff_lambda_q1": nrm(ks[11], (DEPTH, DIFF_QK_DIM), 0.1),
        "diff_lambda_k1": nrm(ks[12], (DEPTH, DIFF_QK_DIM), 0.1),
        "diff_lambda_q2": nrm(ks[13], (DEPTH, DIFF_QK_DIM), 0.1),
        "diff_lambda_k2": nrm(ks[14], (DEPTH, DIFF_QK_DIM), 0.1),
        "diff_head_g": gain(ks[15], (DEPTH, HEAD_DIM)),
        "rel_bias": nrm(ks[16], (N_BUCKETS, H_DIFF), 0.5),
        "ret_decay_fwd": base_logit[None, :] + nrm(ks[17], (DEPTH, H_RET), 0.05),
        "ret_decay_bwd": base_logit[None, :] + nrm(ks[18], (DEPTH, H_RET), 0.05),
        "ret_head_g": gain(ks[19], (DEPTH, HEAD_DIM)),
        "w_out": nrm(ks[20], (DEPTH, MIX_WIDTH, D_MODEL), MIX_WIDTH ** -0.5),
        "ffn2_norm_g": gain(ks[21], (DEPTH, D_MODEL)),
        "ffn2_w13": nrm(ks[22], (DEPTH, D_MODEL, 2 * D_FF), D_MODEL ** -0.5),
        "ffn2_w2": nrm(ks[23], (DEPTH, D_FF, D_MODEL), D_FF ** -0.5),
        "final_norm_g": gain(ks[24], (D_MODEL,)),
    }


def reference(x_prompt, x_sample, c_prompt, c_sample, ada_w, ada_b, ffn1_norm_g, ffn1_w13, ffn1_w2,
              mix_norm_g, w_in, diff_lambda_q1, diff_lambda_k1, diff_lambda_q2, diff_lambda_k2,
              diff_head_g, rel_bias, ret_decay_fwd, ret_decay_bwd, ret_head_g, w_out,
              ffn2_norm_g, ffn2_w13, ffn2_w2, final_norm_g):
    y_prompt = _trunk(x_prompt, c_prompt, ada_w, ada_b, ffn1_norm_g, ffn1_w13, ffn1_w2, mix_norm_g, w_in,
                      diff_lambda_q1, diff_lambda_k1, diff_lambda_q2, diff_lambda_k2, diff_head_g,
                      rel_bias, ret_decay_fwd, ret_decay_bwd, ret_head_g, w_out,
                      ffn2_norm_g, ffn2_w13, ffn2_w2, final_norm_g)
    y_sample = _trunk(x_sample, c_sample, ada_w, ada_b, ffn1_norm_g, ffn1_w13, ffn1_w2, mix_norm_g, w_in,
                      diff_lambda_q1, diff_lambda_k1, diff_lambda_q2, diff_lambda_k2, diff_head_g,
                      rel_bias, ret_decay_fwd, ret_decay_bwd, ret_head_g, w_out,
                      ffn2_norm_g, ffn2_w13, ffn2_w2, final_norm_g)
    return (y_prompt, y_sample)
```

```cpp
#include <hip/hip_runtime.h>
#include <hip/hip_cooperative_groups.h>
#include <cstdio>
#include <cstdint>
namespace cg = cooperative_groups;

#define DI __device__ __forceinline__
#define LAS __attribute__((address_space(3)))
typedef unsigned short bf16_t;
typedef short bf16x8 __attribute__((ext_vector_type(8)));
typedef short s16x4 __attribute__((ext_vector_type(4)));
typedef float f32x4 __attribute__((ext_vector_type(4)));
typedef float f32x16 __attribute__((ext_vector_type(16)));
typedef unsigned u32x4 __attribute__((ext_vector_type(4)));
typedef unsigned u32x2 __attribute__((ext_vector_type(2)));

constexpr int DM = 2048, DFF = 5632, NIN = 7168, TP = 16384, TALL = 24576, NMODW = 18432;
constexpr int LDP = NIN, LDMIX = DM;
constexpr float EPS = 1e-6f, LOG2E = 1.4426950408889634f;
constexpr size_t MiB = 1u << 20;
constexpr size_t WS_MOD = 0, MOD_BYTES = (size_t)8 * NMODW * 4;
constexpr size_t WS_ROPE = 1 * MiB, WS_W13A = 3 * MiB, WS_W2A = 47 * MiB, WS_WIN = 69 * MiB, WS_WOUT = 97 * MiB, WS_W13B = 105 * MiB, WS_W2B = 149 * MiB;
constexpr size_t WS_H = 171 * MiB, WS_PROJ = 267 * MiB, WS_ST = 603 * MiB, WS_BIASM = 651 * MiB, WS_BIAS2 = WS_BIASM + (size_t)8 * NIN * 4, WS_END = 652 * MiB;
constexpr size_t WS_SSQ1 = MOD_BYTES, WS_SSQ2 = WS_SSQ1 + (size_t)TALL * 4, ZERO_BYTES = WS_SSQ2 + (size_t)TALL * 4;
constexpr size_t WS_A2 = 531 * MiB;
constexpr int LDS_BYTES = 147456;

DI unsigned cvtpk(float lo, float hi) { unsigned r; asm volatile("v_cvt_pk_bf16_f32 %0, %1, %2" : "=v"(r) : "v"(lo), "v"(hi)); return r; }
DI bf16_t bf1(float x) { unsigned u = __float_as_uint(x); u += 0x7fffu + ((u >> 16) & 1u); return (bf16_t)(u >> 16); }
DI float bf2f(bf16_t b) { return __uint_as_float((unsigned)b << 16); }
DI float fsilu(float x) { return x * __builtin_amdgcn_rcpf(1.f + __builtin_amdgcn_exp2f(-x * LOG2E)); }
DI int row_b8(int row) { return row < TP ? (row >> 12) : 4 + ((row - TP) >> 11); }
DI int row_pos(int row) { return row < TP ? (row & 4095) : ((row - TP) & 2047); }

namespace pg8 {
constexpr int BM = 256, BK = 64, HALF = 128, HTB = HALF * BK * 2, STAGE_BYTES = 8 * HTB, NXCD = 8, WGM = 8;
DI int lds_byte(int r, int c) { const int st = (r >> 4) * 2 + (c >> 5), rr = r & 15, cc = c & 31, ob = rr * 64 + cc * 2; return st * 1024 + (ob ^ (((ob >> 9) & 1) << 5)); }
DI void stage_rc(int b, int& R, int& C) { const int st = b / 1024, sb = b % 1024, swz = sb ^ (((sb >> 9) & 1) << 5); R = (st >> 1) * 16 + swz / 64; C = (st & 1) * 32 + (swz % 64) / 2; }
DI int perm32(int rho) { const int n = rho >> 4, i = rho & 15; return 8 * (i >> 2) + 4 * n + (i & 3); }
struct Unit { int pm, pn; };
struct Gemm { const bf16_t* A; const bf16_t* Bt; int M, N, K; };
struct StaticOrder {
    int nM, nN, nwg, G, c;
    DI void init(int M, int N, int G_, int c_) { nM = M / BM; nN = N / BM; nwg = nM * nN; G = G_; c = c_; }
    DI bool next(int i, Unit& u) const {
        const long L = (long)i * G + c; if (L >= nwg) return false;
        int wgid = (int)L; { const int q = nwg / NXCD, r = nwg % NXCD, xcd = wgid % NXCD, off = wgid / NXCD; wgid = (xcd < r ? xcd * (q + 1) : r * (q + 1) + (xcd - r) * q) + off; }
        const int nig = WGM * nN, gid = wgid / nig, fm = gid * WGM, gsz = (nM - fm) < WGM ? (nM - fm) : WGM;
        u.pm = fm + ((wgid % nig) % gsz); u.pn = (wgid % nig) / gsz; return true;
    }
};
template <class Epi, bool ALIGN_EPI>
DI void gemm_phase(LAS unsigned char* lds, const Gemm g, const StaticOrder S, const Epi E) {
    int tid_ = threadIdx.x; asm volatile("" : "+v"(tid_));
    const int tid = tid_, wid = __builtin_amdgcn_readfirstlane(tid >> 6), lane = tid & 63, wr = wid >> 2, wc = wid & 3, fr = lane & 15, fq = lane >> 4;
    const int K = g.K, nt = K / BK;
    unsigned voffA[2], voffB[2];
#pragma unroll
    for (int i = 0; i < 2; ++i) { int R, C; stage_rc(tid * 16 + i * 8192, R, C); const int Rb = Epi::PERM ? ((R & ~31) + perm32(R & 31)) : R;
        voffA[i] = (unsigned)(R * K + C) * 2u; voffB[i] = (unsigned)(Rb * K + C) * 2u; }
    const size_t kstep = (size_t)(BK * 2);
    const size_t hstep = (size_t)HALF * K * 2;
    const size_t tstep = 2 * hstep;
    const unsigned ldsw = (unsigned)wid * 1024u;
    const int aoff = lds_byte(wr * 64 + fr, fq * 8), boff = lds_byte(wc * 32 + fr, fq * 8);
#define PG8_SA(b, h) (((b) * 2 + (h)) * HTB)
#define PG8_SB(b, h) ((4 + (b) * 2 + (h)) * HTB)
#define PG8_STAGE(bufoff, gbase, voff) do { _Pragma("unroll") for (int _i = 0; _i < 2; ++_i) \
        __builtin_amdgcn_global_load_lds((const unsigned*)((const char*)(gbase) + (voff)[_i]), (LAS unsigned*)(lds + (bufoff) + ldsw + _i * 8192), 16, 0, 0); } while (0)
#define PG8_LDA(dst, b, h) do { _Pragma("unroll") for (int m = 0; m < 4; ++m) _Pragma("unroll") for (int k = 0; k < 2; ++k) dst[m][k] = *(const LAS bf16x8*)(lds + PG8_SA(b, h) + aoff + m * 2048 + k * 1024); } while (0)
#define PG8_LDB(dst, b, h) do { _Pragma("unroll") for (int n = 0; n < 2; ++n) _Pragma("unroll") for (int k = 0; k < 2; ++k) dst[n][k] = *(const LAS bf16x8*)(lds + PG8_SB(b, h) + boff + n * 2048 + k * 1024); } while (0)
#define PG8_MMA(ai, bj, At, Bt) do { __builtin_amdgcn_s_setprio(1); _Pragma("unroll") for (int m = 0; m < 4; ++m) _Pragma("unroll") for (int n = 0; n < 2; ++n) _Pragma("unroll") for (int k = 0; k < 2; ++k) \
        acc[ai][bj][m][n] = __builtin_amdgcn_mfma_f32_16x16x32_bf16(Bt[n][k], At[m][k], acc[ai][bj][m][n], 0, 0, 0); __builtin_amdgcn_s_setprio(0); } while (0)
#define PG8_WAIT_V(n) asm volatile("s_waitcnt vmcnt(" #n ")" ::: "memory")
#define PG8_WAIT_L(n) asm volatile("s_waitcnt lgkmcnt(" #n ")" ::: "memory")
#define PG8_BAR __builtin_amdgcn_s_barrier()
#define PG8_SCHED __builtin_amdgcn_sched_barrier(0)
    Unit cur, nxt; int ui = 0;
    if (!S.next(0, cur)) return;
    f32x4 acc[2][2][4][2];
#pragma unroll
    for (int a = 0; a < 2; ++a)
#pragma unroll
        for (int b = 0; b < 2; ++b)
#pragma unroll
            for (int m = 0; m < 4; ++m)
#pragma unroll
                for (int n = 0; n < 2; ++n) acc[a][b][m][n] = (f32x4){0.f, 0.f, 0.f, 0.f};
    bf16x8 At[4][2], B0[2][2], B1[2][2];
    const char* cA = (const char*)g.A + (size_t)cur.pm * tstep; const char* cB = (const char*)g.Bt + (size_t)cur.pn * tstep;
    PG8_STAGE(PG8_SB(0, 0), cB, voffB); PG8_STAGE(PG8_SB(0, 1), cB + hstep, voffB); PG8_STAGE(PG8_SA(0, 0), cA, voffA); PG8_STAGE(PG8_SA(0, 1), cA + hstep, voffA);
    if (wr == 1) PG8_BAR;
    PG8_WAIT_V(2); PG8_BAR;
    PG8_STAGE(PG8_SB(1, 0), cB + kstep, voffB); PG8_STAGE(PG8_SA(1, 0), cA + kstep, voffA); PG8_STAGE(PG8_SB(1, 1), cB + hstep + kstep, voffB);
    PG8_WAIT_V(6); PG8_BAR;
    for (;;) {
        const bool has_next = S.next(ui + 1, nxt);
        const char* nA = has_next ? (const char*)g.A + (size_t)nxt.pm * tstep : cA; const char* nB = has_next ? (const char*)g.Bt + (size_t)nxt.pn * tstep : cB;
        for (int t = 0; t < nt; t += 2) {
            const bool last = (t == nt - 2);
            const char* a1 = cA + (size_t)(t + 1) * kstep;
            const char* a2 = last ? nA : cA + (size_t)(t + 2) * kstep; const char* b2 = last ? nB : cB + (size_t)(t + 2) * kstep;
            const char* a3 = a2 + kstep; const char* b3 = b2 + kstep;
            PG8_LDB(B0, 0, 0); PG8_LDB(B1, 0, 1); PG8_SCHED; PG8_LDA(At, 0, 0); PG8_STAGE(PG8_SA(1, 1), a1 + hstep, voffA);
            PG8_WAIT_V(8); PG8_WAIT_L(0); PG8_BAR; PG8_MMA(0, 0, At, B0); PG8_MMA(0, 1, At, B1); PG8_BAR; PG8_SCHED;
            PG8_LDA(At, 0, 1); PG8_STAGE(PG8_SB(0, 0), b2, voffB); PG8_STAGE(PG8_SB(0, 1), b2 + hstep, voffB); PG8_STAGE(PG8_SA(0, 0), a2, voffA);
            PG8_WAIT_V(8); PG8_WAIT_L(0); PG8_BAR; PG8_MMA(1, 0, At, B0); PG8_MMA(1, 1, At, B1); PG8_BAR; PG8_SCHED;
            PG8_LDB(B0, 1, 0); PG8_LDB(B1, 1, 1); PG8_SCHED; PG8_LDA(At, 1, 0); PG8_STAGE(PG8_SA(0, 1), a2 + hstep, voffA);
            PG8_WAIT_V(8); PG8_WAIT_L(0); PG8_BAR; PG8_MMA(0, 0, At, B0); PG8_MMA(0, 1, At, B1); PG8_BAR; PG8_SCHED;
            PG8_LDA(At, 1, 1); PG8_STAGE(PG8_SB(1, 0), b3, voffB); PG8_STAGE(PG8_SB(1, 1), b3 + hstep, voffB); PG8_STAGE(PG8_SA(1, 0), a3, voffA);
            PG8_WAIT_V(8); PG8_WAIT_L(0); PG8_BAR; PG8_MMA(1, 0, At, B0); PG8_MMA(1, 1, At, B1); PG8_BAR; PG8_SCHED;
        }
        if constexpr (ALIGN_EPI) { if (wr == 0) PG8_BAR; }
        { int fr_ = fr, fq_ = fq; asm volatile("" : "+v"(fr_), "+v"(fq_));
          E(acc, cur, wr, wc, fr_, fq_); }
        if (!has_next) break;
#pragma unroll
        for (int a = 0; a < 2; ++a)
#pragma unroll
            for (int b = 0; b < 2; ++b)
#pragma unroll
                for (int m = 0; m < 4; ++m)
#pragma unroll
                    for (int n = 0; n < 2; ++n) acc[a][b][m][n] = (f32x4){0.f, 0.f, 0.f, 0.f};
        cur = nxt; cA = nA; cB = nB; ++ui;
        if constexpr (ALIGN_EPI) { if (wr == 1) PG8_BAR; }
    }
    PG8_WAIT_V(0);
    if constexpr (!ALIGN_EPI) { if (wr == 0) PG8_BAR; }
    PG8_BAR;
#undef PG8_SA
#undef PG8_SB
#undef PG8_STAGE
#undef PG8_LDA
#undef PG8_LDB
#undef PG8_MMA
#undef PG8_WAIT_V
#undef PG8_WAIT_L
#undef PG8_BAR
#undef PG8_SCHED
}

struct EpiSwiGLU {
    static constexpr bool PERM = true;
    bf16_t* O;
    DI void operator()(const f32x4 (&acc)[2][2][4][2], const Unit& u, int wr, int wc, int fr, int fq) const {
        const int row0 = u.pm * BM + wr * 64 + fr, col0 = u.pn * 128 + wc * 32 + 8 * fq;
#pragma unroll
        for (int ai = 0; ai < 2; ++ai)
#pragma unroll
            for (int m = 0; m < 4; ++m) {
                bf16_t* rowp = O + (size_t)(row0 + ai * HALF + m * 16) * DFF + col0;
                const f32x4 g0 = acc[ai][0][m][0], g1 = acc[ai][0][m][1], u0 = acc[ai][1][m][0], u1 = acc[ai][1][m][1];
                float r[8];
#pragma unroll
                for (int j = 0; j < 4; ++j) { r[j] = fsilu(g0[j]) * u0[j]; r[4 + j] = fsilu(g1[j]) * u1[j]; }
                u32x4 w; w.x = cvtpk(r[0], r[1]); w.y = cvtpk(r[2], r[3]); w.z = cvtpk(r[4], r[5]); w.w = cvtpk(r[6], r[7]);
                *(u32x4*)rowp = w;
            }
    }
};
struct EpiResid {
    static constexpr bool PERM = false;
    const float* xa; const float* xb; float* out; const float* gate; float s;
    DI void operator()(const f32x4 (&acc)[2][2][4][2], const Unit& u, int wr, int wc, int fr, int fq) const {
        const int row0t = u.pm * BM; const int b8 = row_b8(row0t);
        const float* gp = gate + (size_t)b8 * NMODW; const int col0 = u.pn * BM + wc * 32 + 4 * fq;
        f32x4 gv[2][2];
#pragma unroll
        for (int bj = 0; bj < 2; ++bj)
#pragma unroll
            for (int n = 0; n < 2; ++n) gv[bj][n] = *(const f32x4*)(gp + col0 + bj * HALF + n * 16) * s;
#pragma unroll
        for (int ai = 0; ai < 2; ++ai)
#pragma unroll
            for (int m = 0; m < 4; ++m) {
                const int row = row0t + ai * HALF + wr * 64 + m * 16 + fr;
                const float* xin = row < TP ? xa + (size_t)row * DM : xb + (size_t)(row - TP) * DM;
                float* op = out + (size_t)row * DM;
#pragma unroll
                for (int bj = 0; bj < 2; ++bj)
#pragma unroll
                    for (int n = 0; n < 2; ++n) { const int c = col0 + bj * HALF + n * 16; const f32x4 xv = *(const f32x4*)(xin + c); *(f32x4*)(op + c) = xv + gv[bj][n] * acc[ai][bj][m][n]; }
            }
    }
};
struct EpiProj {
    static constexpr bool PERM = true;
    bf16_t* O; const float* rope;
    DI void operator()(const f32x4 (&acc)[2][2][4][2], const Unit& u, int wr, int wc, int fr, int fq) const {
        const int row0 = u.pm * BM + wr * 64 + fr, col0 = u.pn * BM + wc * 32 + 8 * fq;
        const int mode = (u.pn >= 12 && u.pn < 20) ? (u.pn >= 16 ? 2 : 1) : 0;
        if (mode == 0) {
#pragma unroll
            for (int ai = 0; ai < 2; ++ai)
#pragma unroll
                for (int m = 0; m < 4; ++m) { bf16_t* rowp = O + (size_t)(row0 + ai * HALF + m * 16) * NIN + col0;
#pragma unroll
                    for (int bj = 0; bj < 2; ++bj) { const f32x4 v0 = acc[ai][bj][m][0], v1 = acc[ai][bj][m][1];
                        u32x4 w; w.x = cvtpk(v0[0], v0[1]); w.y = cvtpk(v0[2], v0[3]); w.z = cvtpk(v1[0], v1[1]); w.w = cvtpk(v1[2], v1[3]);
                        *(u32x4*)(rowp + bj * HALF) = w; } }
        } else {
            const float ksc = mode == 2 ? 0.08838834764831845f : 1.f;
#pragma unroll
            for (int ai = 0; ai < 2; ++ai)
#pragma unroll
                for (int m = 0; m < 4; ++m) { const int row = row0 + ai * HALF + m * 16; bf16_t* rowp = O + (size_t)row * NIN + col0;
                    const float* rp = rope + ((size_t)row_pos(row) * 64 + 16 * wc + 4 * fq) * 2;
                    const f32x4 cs0 = *(const f32x4*)rp, cs1 = *(const f32x4*)(rp + 4);
                    const float cc[4] = {cs0[0] * ksc, cs0[2] * ksc, cs1[0] * ksc, cs1[2] * ksc}, ss[4] = {cs0[1] * ksc, cs0[3] * ksc, cs1[1] * ksc, cs1[3] * ksc};
#pragma unroll
                    for (int bj = 0; bj < 2; ++bj) { const f32x4 x1 = acc[ai][bj][m][0], x2 = acc[ai][bj][m][1]; float o1[4], o2[4];
#pragma unroll
                        for (int j = 0; j < 4; ++j) { o1[j] = x1[j] * cc[j] - x2[j] * ss[j]; o2[j] = x1[j] * ss[j] + x2[j] * cc[j]; }
                        u32x4 w; w.x = cvtpk(o1[0], o1[1]); w.y = cvtpk(o1[2], o1[3]); w.z = cvtpk(o2[0], o2[1]); w.w = cvtpk(o2[2], o2[3]);
                        *(u32x4*)(rowp + bj * HALF) = w; } }
        }
    }
};

template <bool HALFS> struct EpiResidN {
    static constexpr bool PERM = false; static constexpr float s = HALFS ? 0.5f : 1.0f;
    const float* xa; const float* xb; float* out; const float* gate; bf16_t* A2; const float* gn; const float* scn; float* ssq;
    DI void operator()(const f32x4 (&acc)[2][2][4][2], const Unit& u, int wr, int wc, int fr, int fq) const {
        const int row0t = u.pm * BM; const int b8 = row_b8(row0t);
        const float* gp = gate + (size_t)b8 * NMODW; const float* sp = scn + (size_t)b8 * NMODW; const int col0 = u.pn * BM + wc * 32 + 4 * fq;
        f32x4 gv[2][2], gs[2][2];
#pragma unroll
        for (int bj = 0; bj < 2; ++bj)
#pragma unroll
            for (int n = 0; n < 2; ++n) { const int c = col0 + bj * HALF + n * 16; gv[bj][n] = *(const f32x4*)(gp + c) * s; gs[bj][n] = *(const f32x4*)(gn + c) * (*(const f32x4*)(sp + c) + 1.f); }
#pragma unroll
        for (int ai = 0; ai < 2; ++ai)
#pragma unroll
            for (int m = 0; m < 4; ++m) {
                const int row = row0t + ai * HALF + wr * 64 + m * 16 + fr;
                const float* xin = row < TP ? xa + (size_t)row * DM : xb + (size_t)(row - TP) * DM;
                float* op = out + (size_t)row * DM; bf16_t* ap = A2 + (size_t)row * DM; float sq = 0.f;
#pragma unroll
                for (int bj = 0; bj < 2; ++bj)
#pragma unroll
                    for (int n = 0; n < 2; ++n) { const int c = col0 + bj * HALF + n * 16; const f32x4 xv = *(const f32x4*)(xin + c); const f32x4 xn = xv + gv[bj][n] * acc[ai][bj][m][n];
                        *(f32x4*)(op + c) = xn; sq += xn[0] * xn[0] + xn[1] * xn[1] + xn[2] * xn[2] + xn[3] * xn[3];
                        const f32x4 y = xn * gs[bj][n]; u32x2 w; w.x = cvtpk(y[0], y[1]); w.y = cvtpk(y[2], y[3]); *(u32x2*)(ap + c) = w; }
                sq += __shfl_xor(sq, 16); sq += __shfl_xor(sq, 32);
                if (fq == 0) atomicAdd(ssq + row, sq);
            }
    }
};
struct EpiSwiGLUN {
    static constexpr bool PERM = true;
    bf16_t* O; const float* ssq; const float* bias;
    DI void operator()(const f32x4 (&acc)[2][2][4][2], const Unit& u, int wr, int wc, int fr, int fq) const {
        const int row0 = u.pm * BM + wr * 64 + fr, col0 = u.pn * 128 + wc * 32 + 8 * fq;
        const float* bp = bias + (size_t)row_b8(u.pm * BM) * (2 * DFF) + u.pn * BM + wc * 32 + 8 * fq;
        const f32x4 bg0 = *(const f32x4*)bp, bg1 = *(const f32x4*)(bp + 4), bu0 = *(const f32x4*)(bp + HALF), bu1 = *(const f32x4*)(bp + HALF + 4);
#pragma unroll
        for (int ai = 0; ai < 2; ++ai)
#pragma unroll
            for (int m = 0; m < 4; ++m) {
                const int row = row0 + ai * HALF + m * 16;
                const float rstd = __builtin_amdgcn_rsqf(ssq[row] * (1.f / DM) + EPS);
                bf16_t* rowp = O + (size_t)row * DFF + col0;
                const f32x4 g0 = acc[ai][0][m][0] * rstd + bg0, g1 = acc[ai][0][m][1] * rstd + bg1, u0 = acc[ai][1][m][0] * rstd + bu0, u1 = acc[ai][1][m][1] * rstd + bu1;
                float r[8];
#pragma unroll
                for (int j = 0; j < 4; ++j) { r[j] = fsilu(g0[j]) * u0[j]; r[4 + j] = fsilu(g1[j]) * u1[j]; }
                u32x4 w; w.x = cvtpk(r[0], r[1]); w.y = cvtpk(r[2], r[3]); w.z = cvtpk(r[4], r[5]); w.w = cvtpk(r[6], r[7]);
                *(u32x4*)rowp = w;
            }
    }
};
struct EpiProjN {
    static constexpr bool PERM = true;
    bf16_t* O; const float* rope; const float* ssq; const float* bias;
    DI void operator()(const f32x4 (&acc)[2][2][4][2], const Unit& u, int wr, int wc, int fr, int fq) const {
        const int row0 = u.pm * BM + wr * 64 + fr, col0 = u.pn * BM + wc * 32 + 8 * fq;
        const int mode = (u.pn >= 12 && u.pn < 20) ? (u.pn >= 16 ? 2 : 1) : 0;
        const float* bp = bias + (size_t)row_b8(u.pm * BM) * NIN + col0;
        f32x4 bv[2][2];
#pragma unroll
        for (int bj = 0; bj < 2; ++bj)
#pragma unroll
            for (int n = 0; n < 2; ++n) bv[bj][n] = *(const f32x4*)(bp + bj * HALF + 4 * n);
        const float ksc = mode == 2 ? 0.08838834764831845f : 1.f;
#pragma unroll
        for (int ai = 0; ai < 2; ++ai)
#pragma unroll
            for (int m = 0; m < 4; ++m) { const int row = row0 + ai * HALF + m * 16; bf16_t* rowp = O + (size_t)row * NIN + col0;
                const float rstd = __builtin_amdgcn_rsqf(ssq[row] * (1.f / DM) + EPS);
                float cc[4] = {1.f, 1.f, 1.f, 1.f}, ss[4] = {0.f, 0.f, 0.f, 0.f};
                if (mode != 0) { const float* rp = rope + ((size_t)row_pos(row) * 64 + 16 * wc + 4 * fq) * 2;
                    const f32x4 cs0 = *(const f32x4*)rp, cs1 = *(const f32x4*)(rp + 4);
                    cc[0] = cs0[0] * ksc; cc[1] = cs0[2] * ksc; cc[2] = cs1[0] * ksc; cc[3] = cs1[2] * ksc; ss[0] = cs0[1] * ksc; ss[1] = cs0[3] * ksc; ss[2] = cs1[1] * ksc; ss[3] = cs1[3] * ksc; }
#pragma unroll
                for (int bj = 0; bj < 2; ++bj) { const f32x4 x1 = acc[ai][bj][m][0] * rstd + bv[bj][0], x2 = acc[ai][bj][m][1] * rstd + bv[bj][1]; float o1[4], o2[4];
#pragma unroll
                    for (int j = 0; j < 4; ++j) { o1[j] = mode ? x1[j] * cc[j] - x2[j] * ss[j] : x1[j]; o2[j] = mode ? x1[j] * ss[j] + x2[j] * cc[j] : x2[j]; }
                    u32x4 w; w.x = cvtpk(o1[0], o1[1]); w.y = cvtpk(o1[2], o1[3]); w.z = cvtpk(o2[0], o2[1]); w.w = cvtpk(o2[2], o2[3]);
                    *(u32x4*)(rowp + bj * HALF) = w; } }
    }
};
}

namespace att {
constexpr int KVBLK = 64;
constexpr int SHM_V = KVBLK * 128 * 2, SHM_K = KVBLK * 128 * 2;
#define KSWZ(row, colB) ((row) * 256 + ((colB) ^ (((row) & 7) << 4)))
#define SBAR() __builtin_amdgcn_sched_barrier(0)
DI int crow(int r, int hi) { return (r & 3) + 8 * (r >> 2) + 4 * hi; }
DI int v_st(int k, int c) { const int kk = (k & ~0xC) | ((k & 4) << 1) | ((k & 8) >> 1); return ((kk >> 3) * 4 + (c >> 5)) * 512 + ((kk & 7) * 32 + (c & 31)) * 2; }
DI int v_rd_base(int lane) { return ((lane & 3) << 3) | (((lane >> 2) & 3) << 6) | (((lane >> 4) & 1) << 5) | (((lane >> 5) & 1) << 8); }
constexpr int v_rd_off(int d0, int ks, int half) { return d0 * 512 + ks * 4096 + half * 2048; }
template <int OFF> DI s16x4 tr_read(int vb) { s16x4 r; asm volatile("ds_read_b64_tr_b16 %0, %1 offset:%2" : "=&v"(r) : "v"(vb), "i"(OFF) : "memory"); return r; }
#define PKLH(L, H) (bf16x8){L[0], L[1], L[2], L[3], H[0], H[1], H[2], H[3]}
template <int D0> DI void pv_one(f32x16& od, int vb, bf16x8 pa0, bf16x8 pa1, bf16x8 pa2, bf16x8 pa3) {
  const s16x4 l0 = tr_read<v_rd_off(D0, 0, 0)>(vb), h0 = tr_read<v_rd_off(D0, 0, 1)>(vb), l1 = tr_read<v_rd_off(D0, 1, 0)>(vb), h1 = tr_read<v_rd_off(D0, 1, 1)>(vb);
  const s16x4 l2 = tr_read<v_rd_off(D0, 2, 0)>(vb), h2 = tr_read<v_rd_off(D0, 2, 1)>(vb), l3 = tr_read<v_rd_off(D0, 3, 0)>(vb), h3 = tr_read<v_rd_off(D0, 3, 1)>(vb);
  asm volatile("s_waitcnt lgkmcnt(0)" ::: "memory"); SBAR();
  od = __builtin_amdgcn_mfma_f32_32x32x16_bf16(pa0, PKLH(l0, h0), od, 0, 0, 0);
  od = __builtin_amdgcn_mfma_f32_32x32x16_bf16(pa1, PKLH(l1, h1), od, 0, 0, 0);
  od = __builtin_amdgcn_mfma_f32_32x32x16_bf16(pa2, PKLH(l2, h2), od, 0, 0, 0);
  od = __builtin_amdgcn_mfma_f32_32x32x16_bf16(pa3, PKLH(l3, h3), od, 0, 0, 0);
}
DI void pv_d0(f32x16* o, int vb, bf16x8 pa0, bf16x8 pa1, bf16x8 pa2, bf16x8 pa3) {
  pv_one<0>(o[0], vb, pa0, pa1, pa2, pa3); pv_one<1>(o[1], vb, pa0, pa1, pa2, pa3); pv_one<2>(o[2], vb, pa0, pa1, pa2, pa3); pv_one<3>(o[3], vb, pa0, pa1, pa2, pa3);
}
#define PK4(P, BASE, OUT) do { unsigned a0 = cvtpk(P[BASE + 0], P[BASE + 1]), a1 = cvtpk(P[BASE + 2], P[BASE + 3]);   \
    unsigned b0 = cvtpk(P[BASE + 4], P[BASE + 5]), b1 = cvtpk(P[BASE + 6], P[BASE + 7]);                              \
    auto r0 = __builtin_amdgcn_permlane32_swap(a0, b0, false, false); auto r1 = __builtin_amdgcn_permlane32_swap(a1, b1, false, false); \
    u32x4 w = {r0[0], r1[0], r0[1], r1[1]}; OUT = *reinterpret_cast<bf16x8*>(&w); } while (0)

constexpr float C_QK = 0.125f * LOG2E;
constexpr float THRL = 8.f * LOG2E;
typedef float f32x2v __attribute__((ext_vector_type(2)));
DI void partialSM(f32x16& p0, f32x16& p1, float& m_reg, float& alpha, int relbase, int r32, int hi, const float* tbl) {
  float mn;
  const bool far = (relbase - 31 >= 91 || relbase + 63 <= -91);
  float cb = 0.f;
  if (far) { cb = relbase > 0 ? tbl[256] : tbl[0]; }
  else {
    const int base = relbase - r32 + 128;
    for (int r = 0; r < 16; ++r) { int i0 = base + crow(r, hi); int i1 = i0 + 32; i0 = min(max(i0, 0), 256); i1 = min(max(i1, 0), 256);
      p0[r] = fmaf(p0[r], C_QK, tbl[i0]); p1[r] = fmaf(p1[r], C_QK, tbl[i1]); if ((r & 3) == 3) SBAR(); }
  }
  float pmax = fmaxf(p0[0], p0[1]);
  for (int r = 2; r < 16; r += 2) pmax = fmaxf(fmaxf(pmax, p0[r]), p0[r + 1]);
  for (int r = 0; r < 16; r += 2) pmax = fmaxf(fmaxf(pmax, p1[r]), p1[r + 1]);
  { auto rr = __builtin_amdgcn_permlane32_swap(__float_as_uint(pmax), __float_as_uint(pmax), false, false);
    pmax = fmaxf(__uint_as_float(rr[0]), __uint_as_float(rr[1])); }
  const float tmax = far ? fmaf(pmax, C_QK, cb) : pmax;
  if (__builtin_expect(__all(tmax - m_reg <= THRL), 1)) { mn = m_reg; alpha = 1.f; }
  else { mn = fmaxf(m_reg, tmax); alpha = __builtin_amdgcn_exp2f(m_reg - mn); m_reg = mn; }
  SBAR();
  const float scl = far ? C_QK : 1.f, off = far ? cb - mn : -mn;
  const f32x2v sc2 = {scl, scl}, of2 = {off, off};
  for (int r = 0; r < 16; r += 2) { f32x2v v = {p0[r], p0[r + 1]}; v = v * sc2 + of2; p0[r] = v.x; p0[r + 1] = v.y; }
  for (int r = 0; r < 16; r += 2) { f32x2v v = {p1[r], p1[r + 1]}; v = v * sc2 + of2; p1[r] = v.x; p1[r + 1] = v.y; }
  SBAR();
  for (int r = 0; r < 16; ++r) p0[r] = __builtin_amdgcn_exp2f(p0[r]);
}
DI void finishSM(f32x16& p0, f32x16& p1, float alpha, float& l_reg, bf16x8& pa0, bf16x8& pa1, bf16x8& pa2, bf16x8& pa3) {
  for (int r = 0; r < 16; ++r) p1[r] = __builtin_amdgcn_exp2f(p1[r]);
  f32x2v s2 = {0.f, 0.f};
  for (int r = 0; r < 16; r += 2) { const f32x2v a = {p0[r], p0[r + 1]}, b = {p1[r], p1[r + 1]}; s2 = s2 + a; s2 = s2 + b; }
  float ps = s2.x + s2.y;
  { auto rr = __builtin_amdgcn_permlane32_swap(__float_as_uint(ps), __float_as_uint(ps), false, false);
    ps = __uint_as_float(rr[0]) + __uint_as_float(rr[1]); }
  l_reg = l_reg * alpha + ps;
  PK4(p0, 0, pa0); PK4(p0, 8, pa1); PK4(p1, 0, pa2); PK4(p1, 8, pa3);
}
template <int ND0> DI void qkt(f32x16& p0, f32x16& p1, const bf16_t* Ks, const bf16x8* qr, int r32, int hi, int colb0) {
  p0 = f32x16{}; p1 = f32x16{};
#pragma unroll
  for (int d0 = 0; d0 < ND0; ++d0) { int cb = colb0 + (d0 * 16 + hi * 8) * 2;
    bf16x8 b0 = *reinterpret_cast<const bf16x8*>((const char*)Ks + KSWZ(r32, cb));
    bf16x8 b1 = *reinterpret_cast<const bf16x8*>((const char*)Ks + KSWZ(32 + r32, cb));
    p0 = __builtin_amdgcn_mfma_f32_32x32x16_bf16(b0, qr[d0], p0, 0, 0, 0);
    p1 = __builtin_amdgcn_mfma_f32_32x32x16_bf16(b1, qr[d0], p1, 0, 0, 0); }
}
DI int t5_bucket(int rel) {
  const int n = rel < 0 ? -rel : rel;
  int bk = n < 8 ? n : (n < 12 ? 8 : n < 16 ? 9 : n < 23 ? 10 : n < 32 ? 11 : n < 46 ? 12 : n < 64 ? 13 : n < 91 ? 14 : 15);
  return bk + (rel > 0 ? 16 : 0);
}

DI void attn_unit(char* lds, const bf16_t* __restrict__ Qb, const bf16_t* __restrict__ Kh, const bf16_t* __restrict__ Vh, bf16_t* __restrict__ Ob,
                  int seq, int q0, float lam, const float* __restrict__ hg) {
  int tid_ = threadIdx.x; asm volatile("" : "+v"(tid_));
  const int tid = tid_, wid = tid >> 6, lane = tid & 63, r32 = lane & 31, hi = lane >> 5, qg = wid & 3, sm = wid >> 2;
  float* ws = (float*)(lds + 98304) + wid * 64; float* li_l = ws; float* al_l = ws + 32;
  const float* tbl = (const float*)(lds + 98304 + 2048);
  float* xb = (float*)lds;
  float m_reg = -1e30f, l_reg = 0; f32x16 o[4] = {}; bf16x8 qr[4];
  const bf16_t* Qw = Qb + (long)(qg * 32 + r32) * LDP + sm * 64 + hi * 8;
#pragma unroll
  for (int d0 = 0; d0 < 4; ++d0) qr[d0] = *reinterpret_cast<const bf16x8*>(Qw + d0 * 16);
  const int colb0 = sm * 128;
  const int qw0 = q0 + qg * 32;
  const int sr = tid >> 4, sc = (tid & 15) * 8, vst0 = v_st(sr, sc), vst1 = v_st(32 + sr, sc);
  const int vb0 = (int)(uintptr_t)lds + v_rd_base(lane);
  constexpr int SDEPTH = 2;
  struct { bf16x8 vs0, vs1, ks0, ks1; } sr_[SDEPTH];
#define SLOAD(i, k0) do { sr_[i].vs0 = *(const bf16x8*)(&Vh[(long)((k0) + sr) * LDP + sc]); sr_[i].vs1 = *(const bf16x8*)(&Vh[(long)((k0) + 32 + sr) * LDP + sc]); \
    sr_[i].ks0 = *(const bf16x8*)(&Kh[(long)((k0) + sr) * LDP + sc]); sr_[i].ks1 = *(const bf16x8*)(&Kh[(long)((k0) + 32 + sr) * LDP + sc]); } while (0)
#define SWRITE(boff, i) do { char* vb_ = lds + (boff); char* kb_ = vb_ + 16384; *(bf16x8*)(vb_ + vst0) = sr_[i].vs0;          \
    *(bf16x8*)(vb_ + vst1) = sr_[i].vs1; int kc = sc * 2;               \
    *(bf16x8*)(kb_ + KSWZ(sr, kc)) = sr_[i].ks0;                       \
    *(bf16x8*)(kb_ + KSWZ(32 + sr, kc)) = sr_[i].ks1; } while (0)
#define SWAIT() do { if constexpr (SDEPTH == 2) asm volatile("s_waitcnt vmcnt(4)" ::: "memory"); else asm volatile("s_waitcnt vmcnt(0)" ::: "memory"); } while (0)
#define RESC(a) do { if (__any((a) < 1.f)) { if (hi == 0) al_l[r32] = (a); asm volatile("s_waitcnt lgkmcnt(0)" ::: "memory"); \
    for (int d = 0; d < 4; ++d) for (int r = 0; r < 16; ++r) o[d][r] *= al_l[crow(r, hi)]; } } while (0)
  f32x16 pA0, pA1, pB0, pB1; float alA, alB; bf16x8 pa0, pa1, pa2, pa3; const int NT = seq / KVBLK;
  constexpr int SE = 0, SO = SDEPTH - 1;
  static_assert(SDEPTH == 2, "3-buffer ring below is written for SDEPTH 2");
#define KB(off) ((const bf16_t*)(lds + (off) + 16384))
  int bP = 0, bC = 32768, bN = 65536;
  SLOAD(SE, 0); asm volatile("s_waitcnt vmcnt(0)" ::: "memory"); SWRITE(0, SE); __syncthreads();
  qkt<4>(pA0, pA1, KB(0), qr, r32, hi, colb0); partialSM(pA0, pA1, m_reg, alA, 0 - qw0, r32, hi, tbl);
  SLOAD(SO, KVBLK); if (2 < NT) SLOAD(SE, 2 * KVBLK);
  SWAIT(); SWRITE(32768, SO); __syncthreads();
  for (int j = 1; j + 1 < NT; j += 2) {
    SBAR(); qkt<4>(pB0, pB1, KB(bC), qr, r32, hi, colb0);
    finishSM(pA0, pA1, alA, l_reg, pa0, pa1, pa2, pa3); SBAR();
    SLOAD(SO, (j + 2) * KVBLK); SBAR();
    pv_d0(o, vb0 + bP, pa0, pa1, pa2, pa3); partialSM(pB0, pB1, m_reg, alB, j * KVBLK - qw0, r32, hi, tbl);
    SWAIT(); SWRITE(bN, SE);
    RESC(alB); __syncthreads();
    SBAR(); qkt<4>(pA0, pA1, KB(bN), qr, r32, hi, colb0);
    finishSM(pB0, pB1, alB, l_reg, pa0, pa1, pa2, pa3); SBAR();
    if (j + 3 < NT) SLOAD(SE, (j + 3) * KVBLK); SBAR();
    pv_d0(o, vb0 + bC, pa0, pa1, pa2, pa3); partialSM(pA0, pA1, m_reg, alA, (j + 1) * KVBLK - qw0, r32, hi, tbl);
    SWAIT(); SWRITE(bP, SO);
    RESC(alA); __syncthreads();
    { const int t_ = bP; bP = bN; bN = bC; bC = t_; }
  }
  SBAR(); qkt<4>(pB0, pB1, KB(bC), qr, r32, hi, colb0);
  finishSM(pA0, pA1, alA, l_reg, pa0, pa1, pa2, pa3); SBAR();
  pv_d0(o, vb0 + bP, pa0, pa1, pa2, pa3); partialSM(pB0, pB1, m_reg, alB, (NT - 1) * KVBLK - qw0, r32, hi, tbl);
  RESC(alB);
  finishSM(pB0, pB1, alB, l_reg, pa0, pa1, pa2, pa3); SBAR();
  pv_d0(o, vb0 + bC, pa0, pa1, pa2, pa3);
#undef KB
  if (hi == 0) li_l[r32] = l_reg; asm volatile("s_waitcnt lgkmcnt(0)" ::: "memory");
  float rli[16];
  const float sgn = sm ? -lam : 1.f;
#pragma unroll
  for (int r = 0; r < 16; ++r) rli[r] = __builtin_amdgcn_rcpf(li_l[crow(r, hi)]) * sgn;
  __syncthreads();
  if (sm == 1) {
#pragma unroll
    for (int d0 = 0; d0 < 4; ++d0)
#pragma unroll
      for (int r = 0; r < 16; ++r) xb[((qg * 4 + d0) * 16 + r) * 64 + lane] = o[d0][r] * rli[r];
  }
  __syncthreads();
  if (sm == 0) {
    float g4[4];
#pragma unroll
    for (int d0 = 0; d0 < 4; ++d0) g4[d0] = hg[d0 * 32 + r32] * 0.8f;
    char* myl = lds + 104448 + qg * 8704;
#pragma unroll
    for (int r = 0; r < 16; ++r) {
      float v[4]; float ss = 0.f;
#pragma unroll
      for (int d0 = 0; d0 < 4; ++d0) { v[d0] = o[d0][r] * rli[r] + xb[((qg * 4 + d0) * 16 + r) * 64 + lane]; ss += v[d0] * v[d0]; }
      ss += __shfl_xor(ss, 1); ss += __shfl_xor(ss, 2); ss += __shfl_xor(ss, 4); ss += __shfl_xor(ss, 8); ss += __shfl_xor(ss, 16);
      const float rs = __builtin_amdgcn_rsqf(ss * (1.f / 128.f) + EPS);
      char* lp = myl + (((r & 3) + 8 * (r >> 2)) + 4 * hi) * 272 + r32 * 2;
#pragma unroll
      for (int d0 = 0; d0 < 4; ++d0) *(bf16_t*)(lp + d0 * 64) = bf1(v[d0] * rs * g4[d0]);
    }
    asm volatile("s_waitcnt lgkmcnt(0)" ::: "memory");
    int rb = qg * 32; asm volatile("" : "+v"(rb));
#pragma unroll
    for (int i = 0; i < 8; ++i) { const int c = lane + 64 * i, row = c >> 4, c8 = (c & 15) * 8;
      *(u32x4*)(Ob + (long)(rb + row) * LDMIX + c8) = *(const u32x4*)(myl + row * 272 + c8 * 2); }
  }
  __syncthreads();
#undef SLOAD
#undef SWRITE
#undef SWAIT
#undef RESC
}

DI bf16x8 scale8(bf16x8 v, float s) {
  u32x4 w = *reinterpret_cast<u32x4*>(&v); u32x4 o;
#pragma unroll
  for (int i = 0; i < 4; ++i) { const float lo = __uint_as_float(w[i] << 16), hi = __uint_as_float(w[i] & 0xffff0000u); o[i] = cvtpk(lo * s, hi * s); }
  return *reinterpret_cast<bf16x8*>(&o);
}

DI void ret_state_unit(char* lds, const bf16_t* __restrict__ Kh, const bf16_t* __restrict__ Vh, bf16_t* __restrict__ St  , float lf, float lb) {
  int tid_ = threadIdx.x; asm volatile("" : "+v"(tid_));
  const int tid = tid_, wid = tid >> 6, lane = tid & 63, r32 = lane & 31, hi = lane >> 5, dir = wid >> 2, a0 = wid & 3;
  char* Ki = lds; char* Vi = lds + SHM_V;
  const int sr = tid >> 4, sc = (tid & 15) * 8, vst0 = v_st(sr, sc), vst1 = v_st(32 + sr, sc);
  const int kb = (int)(uintptr_t)Ki + v_rd_base(lane) + a0 * 512, vb = (int)(uintptr_t)Vi + v_rd_base(lane);
  const float lg = dir ? lb : lf;
  f32x16 acc[4] = {};
  bf16x8 k0v, k1v, v0v, v1v;
#define R1_LOAD(k0) do { k0v = *(const bf16x8*)(&Kh[(long)((k0) + sr) * LDP + sc]); k1v = *(const bf16x8*)(&Kh[(long)((k0) + 32 + sr) * LDP + sc]); \
    v0v = *(const bf16x8*)(&Vh[(long)((k0) + sr) * LDP + sc]); v1v = *(const bf16x8*)(&Vh[(long)((k0) + 32 + sr) * LDP + sc]); } while (0)
  R1_LOAD(0);
  for (int t = 0; t < 4; ++t) {
    __syncthreads();
    *(bf16x8*)(Ki + vst0) = k0v; *(bf16x8*)(Ki + vst1) = k1v; *(bf16x8*)(Vi + vst0) = v0v; *(bf16x8*)(Vi + vst1) = v1v;
    __syncthreads();
    if (t < 3) R1_LOAD((t + 1) * 64);
#define RSTEP(KS) do { \
    const s16x4 la = tr_read<v_rd_off(0, KS, 0)>(kb), ha = tr_read<v_rd_off(0, KS, 1)>(kb); \
    const s16x4 l0 = tr_read<v_rd_off(0, KS, 0)>(vb), h0 = tr_read<v_rd_off(0, KS, 1)>(vb), l1 = tr_read<v_rd_off(1, KS, 0)>(vb), h1 = tr_read<v_rd_off(1, KS, 1)>(vb); \
    const s16x4 l2 = tr_read<v_rd_off(2, KS, 0)>(vb), h2 = tr_read<v_rd_off(2, KS, 1)>(vb), l3 = tr_read<v_rd_off(3, KS, 0)>(vb), h3 = tr_read<v_rd_off(3, KS, 1)>(vb); \
    asm volatile("s_waitcnt lgkmcnt(0)" ::: "memory"); SBAR(); \
    bf16x8 A = PKLH(la, ha); \
    { const int tok0 = t * 64 + 16 * KS + 8 * hi; u32x4 w = *reinterpret_cast<u32x4*>(&A); u32x4 ow; \
      _Pragma("unroll") for (int i = 0; i < 4; ++i) { const int ta = tok0 + 2 * i, tb2 = ta + 1; \
        const float za = __builtin_amdgcn_exp2f(lg * (float)(dir ? ta : 255 - ta)), zb = __builtin_amdgcn_exp2f(lg * (float)(dir ? tb2 : 255 - tb2)); \
        ow[i] = cvtpk(__uint_as_float(w[i] << 16) * za, __uint_as_float(w[i] & 0xffff0000u) * zb); } \
      A = *reinterpret_cast<bf16x8*>(&ow); } \
    acc[0] = __builtin_amdgcn_mfma_f32_32x32x16_bf16(A, PKLH(l0, h0), acc[0], 0, 0, 0); \
    acc[1] = __builtin_amdgcn_mfma_f32_32x32x16_bf16(A, PKLH(l1, h1), acc[1], 0, 0, 0); \
    acc[2] = __builtin_amdgcn_mfma_f32_32x32x16_bf16(A, PKLH(l2, h2), acc[2], 0, 0, 0); \
    acc[3] = __builtin_amdgcn_mfma_f32_32x32x16_bf16(A, PKLH(l3, h3), acc[3], 0, 0, 0); } while (0)
    RSTEP(0); RSTEP(1); RSTEP(2); RSTEP(3);
#undef RSTEP
  }
#undef R1_LOAD
  bf16_t* sp = St + (size_t)dir * 16384;
#pragma unroll
  for (int d0 = 0; d0 < 4; ++d0)
#pragma unroll
    for (int r = 0; r < 16; ++r) sp[(32 * a0 + crow(r, hi)) * 128 + 32 * d0 + r32] = bf1(acc[d0][r]);
  __syncthreads();
}

DI void ret_out_unit(char* lds, const bf16_t* __restrict__ Qb, const bf16_t* __restrict__ Kh, const bf16_t* __restrict__ Vh, const bf16_t* __restrict__ Gb,
                     const bf16_t* __restrict__ St  , bf16_t* __restrict__ Ob, float lf, float lb, const float* __restrict__ hg) {
  int tid_ = threadIdx.x; asm volatile("" : "+v"(tid_));
  const int tid = tid_, wid = tid >> 6, lane = tid & 63, r32 = lane & 31, hi = lane >> 5;
  char* Vi = lds; char* Ki = lds + 2 * SHM_V;
  const int sr = tid >> 4, sc = (tid & 15) * 8, vst0 = v_st(sr, sc), vst1 = v_st(32 + sr, sc);
  const int vb = (int)(uintptr_t)Vi + v_rd_base(lane);
  bf16x8 qr[8]; f32x16 o[4] = {};
  const int nl = wid * 32 + r32;
  const bf16_t* Qw = Qb + (long)nl * LDP + hi * 8;
#pragma unroll
  for (int d0 = 0; d0 < 8; ++d0) qr[d0] = *reinterpret_cast<const bf16x8*>(Qw + d0 * 16);
  bf16x8 k0v, k1v, v0v, v1v;
#define R3_LOADKV(k0) do { k0v = *(const bf16x8*)(&Kh[(long)((k0) + sr) * LDP + sc]); k1v = *(const bf16x8*)(&Kh[(long)((k0) + 32 + sr) * LDP + sc]); \
    v0v = *(const bf16x8*)(&Vh[(long)((k0) + sr) * LDP + sc]); v1v = *(const bf16x8*)(&Vh[(long)((k0) + 32 + sr) * LDP + sc]); } while (0)
#define R3_LOADR(dir, half) do { const bf16_t* Rp_ = St + (size_t)(dir) * 16384; v0v = *(const bf16x8*)(&Rp_[((half) * 64 + sr) * 128 + sc]); v1v = *(const bf16x8*)(&Rp_[((half) * 64 + 32 + sr) * 128 + sc]); } while (0)
  R3_LOADKV(0);
  for (int t = 0; t < 4; ++t) {
    __syncthreads();
    { const int kc = sc * 2;
      *(bf16x8*)(Ki + KSWZ(sr, kc)) = k0v; *(bf16x8*)(Ki + KSWZ(32 + sr, kc)) = k1v; *(bf16x8*)(Vi + vst0) = v0v; *(bf16x8*)(Vi + vst1) = v1v; }
    __syncthreads();
    if (t < 3) R3_LOADKV((t + 1) * 64); else R3_LOADR(0, 0);
    f32x16 p0, p1; qkt<8>(p0, p1, (const bf16_t*)Ki, qr, r32, hi, 0);
#pragma unroll
    for (int r = 0; r < 16; ++r) {
      const int d0_ = nl - (t * 64 + crow(r, hi)), d1_ = d0_ - 32;
      p0[r] *= __builtin_amdgcn_exp2f(d0_ >= 0 ? lf * (float)d0_ : lb * (float)(-d0_));
      p1[r] *= __builtin_amdgcn_exp2f(d1_ >= 0 ? lf * (float)d1_ : lb * (float)(-d1_));
      if ((r & 3) == 3) SBAR();
    }
    bf16x8 pa0, pa1, pa2, pa3;
    PK4(p0, 0, pa0); PK4(p0, 8, pa1); PK4(p1, 0, pa2); PK4(p1, 8, pa3);
    pv_d0(o, vb, pa0, pa1, pa2, pa3);
  }
#pragma unroll
  for (int dir = 0; dir < 2; ++dir) {
    const float xi = __builtin_amdgcn_exp2f(dir ? lb * (float)(256 - nl) : lf * (float)(nl + 1));
#pragma unroll
    for (int half = 0; half < 2; ++half) {
      __syncthreads();
      *(bf16x8*)(Vi + vst0) = v0v; *(bf16x8*)(Vi + vst1) = v1v;
      __syncthreads();
      if (dir * 2 + half < 3) R3_LOADR((dir * 2 + half + 1) >> 1, (dir * 2 + half + 1) & 1);
      pv_d0(o, vb, scale8(qr[half * 4 + 0], xi), scale8(qr[half * 4 + 1], xi), scale8(qr[half * 4 + 2], xi), scale8(qr[half * 4 + 3], xi));
    }
  }
#undef R3_LOADKV
#undef R3_LOADR
  float g4[4];
#pragma unroll
  for (int d0 = 0; d0 < 4; ++d0) g4[d0] = hg[d0 * 32 + r32];
  __syncthreads();
  char* myl = lds + wid * 8704;
  u32x4 gt[8];
  int rb = wid * 32; asm volatile("" : "+v"(rb));
#pragma unroll
  for (int i = 0; i < 8; ++i) { const int c = lane + 64 * i; gt[i] = *(const u32x4*)(Gb + (long)(rb + (c >> 4)) * LDP + (c & 15) * 8); }
#pragma unroll
  for (int r = 0; r < 16; ++r) {
    float ss = 0.f;
#pragma unroll
    for (int d0 = 0; d0 < 4; ++d0) ss += o[d0][r] * o[d0][r];
    ss += __shfl_xor(ss, 1); ss += __shfl_xor(ss, 2); ss += __shfl_xor(ss, 4); ss += __shfl_xor(ss, 8); ss += __shfl_xor(ss, 16);
    const float rs = __builtin_amdgcn_rsqf(ss * (1.f / 128.f) + EPS);
    char* lp = myl + (((r & 3) + 8 * (r >> 2)) + 4 * hi) * 272 + r32 * 2;
#pragma unroll
    for (int d0 = 0; d0 < 4; ++d0) *(bf16_t*)(lp + d0 * 64) = bf1(o[d0][r] * rs * g4[d0]);
  }
  asm volatile("s_waitcnt lgkmcnt(0)" ::: "memory");
#pragma unroll
  for (int i = 0; i < 8; ++i) { const int c = lane + 64 * i, row = c >> 4, c8 = (c & 15) * 8;
    const u32x4 v = *(const u32x4*)(myl + row * 272 + c8 * 2); u32x4 w;
#pragma unroll
    for (int j = 0; j < 4; ++j) { const float glo = __uint_as_float(gt[i][j] << 16), ghi = __uint_as_float(gt[i][j] & 0xffff0000u);
      w[j] = cvtpk(__uint_as_float(v[j] << 16) * fsilu(glo), __uint_as_float(v[j] & 0xffff0000u) * fsilu(ghi)); }
    *(u32x4*)(Ob + (long)(rb + row) * LDMIX + c8) = w; }
  __syncthreads();
}
}

struct Params { const float* in[25]; float* out; unsigned char* ws; };

DI int srcmap(int mode, int np) {
  if (mode == 1) { const int pn = np >> 8, bj = (np >> 7) & 1, i = np & 127; return bj * DFF + pn * 128 + i; }
  if (mode == 2 && np >= 3072 && np < 5120) { const int p = np & 127, wc = p >> 5, fq = (p >> 3) & 3, n = (p >> 2) & 1, j = p & 3; return (np & ~127) + 64 * n + 16 * wc + 4 * fq + j; }
  return np;
}
DI void convert_tile(const float* __restrict__ W, bf16_t* __restrict__ Bt, int K, int N, int mode, int tile, float* tl) {
  const int ntn = N >> 6, kt = tile / ntn, nt = tile - kt * ntn, k0 = kt * 64, n0 = nt * 64, tid = threadIdx.x;
  { const int kl = tid >> 3, c8 = (tid & 7) * 8;
#pragma unroll
    for (int q = 0; q < 2; ++q) { const int src = srcmap(mode, n0 + c8 + 4 * q); const f32x4 v = *(const f32x4*)(W + (size_t)(k0 + kl) * N + src);
      float* d = tl + kl * 65 + c8 + 4 * q; d[0] = v[0]; d[1] = v[1]; d[2] = v[2]; d[3] = v[3]; } }
  __syncthreads();
  { const int nl = tid >> 3, kc = (tid & 7) * 8; float r[8];
#pragma unroll
    for (int i = 0; i < 8; ++i) r[i] = tl[(kc + i) * 65 + nl];
    u32x4 w; w.x = cvtpk(r[0], r[1]); w.y = cvtpk(r[2], r[3]); w.z = cvtpk(r[4], r[5]); w.w = cvtpk(r[6], r[7]);
    *(u32x4*)(Bt + (size_t)(n0 + nl) * K + k0 + kc) = w; }
  __syncthreads();
}
DI void mod_item(const Params& p, int item, float* red, float* mod) {
  const int tid = threadIdx.x, wid = tid >> 6, lane = tid & 63;
  const int cgp = item % 72, ks = item / 72, col = cgp * 256 + lane * 4, k0 = ks * 256 + wid * 32;
  const float* aw = p.in[4];
  f32x4 acc[8];
#pragma unroll
  for (int b = 0; b < 8; ++b) acc[b] = (f32x4){0.f, 0.f, 0.f, 0.f};
#pragma unroll 16
  for (int kk = 0; kk < 32; ++kk) { const int k = k0 + kk; const f32x4 w = *(const f32x4*)(aw + (size_t)k * NMODW + col);
#pragma unroll
    for (int b = 0; b < 8; ++b) { const float c = b < 4 ? p.in[2][b * DM + k] : p.in[3][(b - 4) * DM + k]; acc[b] += w * fsilu(c); } }
#pragma unroll
  for (int b = 0; b < 8; ++b) *(f32x4*)(red + ((wid * 8 + b) * 256) + lane * 4) = acc[b];
  __syncthreads();
  { const int o = tid * 4, b = o >> 8, c = o & 255; f32x4 s = (f32x4){0.f, 0.f, 0.f, 0.f};
#pragma unroll
    for (int w = 0; w < 8; ++w) s += *(const f32x4*)(red + ((w * 8 + b) * 256) + c);
    if (ks == 0) s += *(const f32x4*)(p.in[5] + cgp * 256 + c);
    float* mp = mod + (size_t)b * NMODW + cgp * 256 + c;
    atomicAdd(mp + 0, s[0]); atomicAdd(mp + 1, s[1]); atomicAdd(mp + 2, s[2]); atomicAdd(mp + 3, s[3]); }
  __syncthreads();
}
DI void norm_mod_phase(const float* xa, const float* xb, const float* __restrict__ g, const float* __restrict__ mod, int shi, int sci, bf16_t* __restrict__ h) {
  int t_ = threadIdx.x; asm volatile("" : "+v"(t_));
  const int wid = t_ >> 6, lane = t_ & 63;
  for (int row = blockIdx.x * 8 + wid; row < TALL; row += gridDim.x * 8) {
    const float* xr = row < TP ? xa + (size_t)row * DM : xb + (size_t)(row - TP) * DM;
    const float* mp = mod + (size_t)row_b8(row) * NMODW;
    f32x4 v[8]; float ss = 0.f;
#pragma unroll
    for (int i = 0; i < 8; ++i) { v[i] = *(const f32x4*)(xr + i * 256 + lane * 4); ss += v[i][0] * v[i][0] + v[i][1] * v[i][1] + v[i][2] * v[i][2] + v[i][3] * v[i][3]; }
    ss += __shfl_xor(ss, 1); ss += __shfl_xor(ss, 2); ss += __shfl_xor(ss, 4); ss += __shfl_xor(ss, 8); ss += __shfl_xor(ss, 16); ss += __shfl_xor(ss, 32);
    const float rstd = __builtin_amdgcn_rsqf(ss * (1.f / DM) + EPS);
#pragma unroll
    for (int i = 0; i < 8; ++i) { const int c = i * 256 + lane * 4;
      const f32x4 gg = *(const f32x4*)(g + c), sc = *(const f32x4*)(mp + sci * DM + c), sh = *(const f32x4*)(mp + shi * DM + c);
      const f32x4 y = v[i] * rstd * gg * (sc + 1.f) + sh;
      u32x2 w; w.x = cvtpk(y[0], y[1]); w.y = cvtpk(y[2], y[3]); *(u32x2*)(h + (size_t)row * DM + c) = w; }
  }
}
DI void bias_phase(const float* __restrict__ sh, const bf16_t* __restrict__ Wt, int N, float* __restrict__ bias, float* lsh) {
  int t_ = threadIdx.x; asm volatile("" : "+v"(t_));
  const int tid = t_, wid = tid >> 6, lane = tid & 63;
  __syncthreads();
  for (int i = tid; i < 8 * DM / 4; i += 512) { const int b = i >> 9, c4 = (i & 511) * 4; *(f32x4*)(lsh + b * DM + c4) = *(const f32x4*)(sh + (size_t)b * NMODW + c4); }
  __syncthreads();
  for (int col = blockIdx.x * 8 + wid; col < N; col += gridDim.x * 8) {
    const bf16_t* wrow = Wt + (size_t)col * DM;
    float a[8];
#pragma unroll
    for (int b = 0; b < 8; ++b) a[b] = 0.f;
#pragma unroll 1
    for (int i = 0; i < 4; ++i) { const int k = i * 512 + lane * 8; const u32x4 w = *(const u32x4*)(wrow + k); float wf[8];
#pragma unroll
      for (int j = 0; j < 4; ++j) { wf[2 * j] = __uint_as_float(w[j] << 16); wf[2 * j + 1] = __uint_as_float(w[j] & 0xffff0000u); }
#pragma unroll
      for (int b = 0; b < 8; ++b) { const f32x4 s0 = *(const f32x4*)(lsh + b * DM + k), s1 = *(const f32x4*)(lsh + b * DM + k + 4);
        a[b] += wf[0] * s0[0] + wf[1] * s0[1] + wf[2] * s0[2] + wf[3] * s0[3] + wf[4] * s1[0] + wf[5] * s1[1] + wf[6] * s1[2] + wf[7] * s1[3]; } }
#pragma unroll
    for (int b = 0; b < 8; ++b) { float v = a[b]; v += __shfl_xor(v, 1); v += __shfl_xor(v, 2); v += __shfl_xor(v, 4); v += __shfl_xor(v, 8); v += __shfl_xor(v, 16); v += __shfl_xor(v, 32);
      if (lane == 0) bias[(size_t)b * N + col] = v; }
  }
  __syncthreads();
}
DI void final_norm_phase(float* out, const float* __restrict__ g) {
  int t_ = threadIdx.x; asm volatile("" : "+v"(t_));
  const int wid = t_ >> 6, lane = t_ & 63;
  for (int row = blockIdx.x * 8 + wid; row < TALL; row += gridDim.x * 8) {
    float* xr = out + (size_t)row * DM;
    f32x4 v[8]; float ss = 0.f;
#pragma unroll
    for (int i = 0; i < 8; ++i) { v[i] = *(const f32x4*)(xr + i * 256 + lane * 4); ss += v[i][0] * v[i][0] + v[i][1] * v[i][1] + v[i][2] * v[i][2] + v[i][3] * v[i][3]; }
    ss += __shfl_xor(ss, 1); ss += __shfl_xor(ss, 2); ss += __shfl_xor(ss, 4); ss += __shfl_xor(ss, 8); ss += __shfl_xor(ss, 16); ss += __shfl_xor(ss, 32);
    const float rstd = __builtin_amdgcn_rsqf(ss * (1.f / DM) + EPS);
#pragma unroll
    for (int i = 0; i < 8; ++i) { const int c = i * 256 + lane * 4; *(f32x4*)(xr + c) = v[i] * rstd * *(const f32x4*)(g + c); }
  }
}
DI float log2_gamma(float x) {
  const float u = __expf(-x);
  float l;
  if (u < 0.05f) l = u * (1.f - u * (0.5f - u * (1.f / 3.f - u * (0.25f - u * (0.2f - u * (1.f / 6.f))))));
  else l = __logf(1.f + u);
  return -l * LOG2E;
}

#ifndef PHMASK
#define PHMASK 0xFFFF
#endif
#define PH(k) if constexpr ((PHMASK >> (k)) & 1)
#ifndef DBLMASK
#define DBLMASK 0
#endif
#define REP(k) for (int rep_ = 0; rep_ < (((DBLMASK) >> (k)) & 1) + 1; ++rep_)
__global__ void __launch_bounds__(512, 2) fwd_mega(Params p) {
  extern __shared__ __attribute__((aligned(16))) unsigned char lds[];
  cg::grid_group grid = cg::this_grid();
  const int tid = threadIdx.x, G = gridDim.x, bid = blockIdx.x;
  unsigned char* ws = p.ws;
  float* mod = (float*)(ws + WS_MOD); float* rope = (float*)(ws + WS_ROPE);
  bf16_t* w13a = (bf16_t*)(ws + WS_W13A); bf16_t* w2a = (bf16_t*)(ws + WS_W2A); bf16_t* win = (bf16_t*)(ws + WS_WIN); bf16_t* wout = (bf16_t*)(ws + WS_WOUT);
  bf16_t* w13b = (bf16_t*)(ws + WS_W13B); bf16_t* w2b = (bf16_t*)(ws + WS_W2B);
  bf16_t* hbuf = (bf16_t*)(ws + WS_H); bf16_t* proj = (bf16_t*)(ws + WS_PROJ); bf16_t* act = proj; bf16_t* mix = hbuf; bf16_t* st = (bf16_t*)(ws + WS_ST);
  float* out = p.out;
  float* ssq1 = (float*)(ws + WS_SSQ1); float* ssq2 = (float*)(ws + WS_SSQ2); float* biasM = (float*)(ws + WS_BIASM); float* bias2 = (float*)(ws + WS_BIAS2); bf16_t* a2buf = (bf16_t*)(ws + WS_A2);
  LAS unsigned char* ldsl = (LAS unsigned char*)lds;

  PH(0) {
    for (int it = bid; it < 576; it += G) mod_item(p, it, (float*)lds, mod);
    REP(0) for (int it = bid; it < 21504; it += G) {
      const float* W; bf16_t* Bt; int K, N, mode, tile = it;
      if (tile < 5632) { W = p.in[7]; Bt = w13a; K = DM; N = 2 * DFF; mode = 1; }
      else if ((tile -= 5632) < 2816) { W = p.in[8]; Bt = w2a; K = DFF; N = DM; mode = 0; }
      else if ((tile -= 2816) < 3584) { W = p.in[10]; Bt = win; K = DM; N = NIN; mode = 2; }
      else if ((tile -= 3584) < 1024) { W = p.in[20]; Bt = wout; K = DM; N = DM; mode = 0; }
      else if ((tile -= 1024) < 5632) { W = p.in[22]; Bt = w13b; K = DM; N = 2 * DFF; mode = 1; }
      else { tile -= 5632; W = p.in[23]; Bt = w2b; K = DFF; N = DM; mode = 0; }
      convert_tile(W, Bt, K, N, mode, tile, (float*)lds);
    }
    for (int e = bid * 512 + tid; e < 4096 * 64; e += G * 512) {
      const int pos = e >> 6, i = e & 63;
      const float inv = __builtin_amdgcn_exp2f(-(float)i * (13.287712379549449f / 64.f));
      const float ang = (float)pos * inv;
      double rev = (double)ang * 0.15915494309189535; rev -= __builtin_rint(rev);
      const float fr = (float)rev;
      rope[2 * e] = __builtin_amdgcn_cosf(fr); rope[2 * e + 1] = __builtin_amdgcn_sinf(fr);
    }
  }
  grid.sync();
  PH(1) REP(1) { norm_mod_phase(p.in[0], p.in[1], p.in[6], mod, 0, 1, hbuf);
    bias_phase(mod + 3 * DM, win, NIN, biasM, (float*)lds); bias_phase(mod + 6 * DM, w13b, 2 * DFF, bias2, (float*)lds); }
  grid.sync();
  PH(2) REP(2) { pg8::Gemm g{hbuf, w13a, TALL, 2 * DFF, DM}; pg8::StaticOrder S; S.init(TALL, 2 * DFF, G, bid); pg8::EpiSwiGLU E{act}; pg8::gemm_phase<pg8::EpiSwiGLU, true>(ldsl, g, S, E); }
  grid.sync();
  PH(3) REP(3) { pg8::Gemm g{act, w2a, TALL, DM, DFF}; pg8::StaticOrder S; S.init(TALL, DM, G, bid); pg8::EpiResidN<true> E{p.in[0], p.in[1], out, mod + 2 * DM, hbuf, p.in[9], mod + 4 * DM, ssq1}; pg8::gemm_phase<pg8::EpiResidN<true>, true>(ldsl, g, S, E); }
  grid.sync();
  PH(5) REP(5) { pg8::Gemm g{hbuf, win, TALL, NIN, DM}; pg8::StaticOrder S; S.init(TALL, NIN, G, bid); pg8::EpiProjN E{proj, rope, ssq1, biasM}; pg8::gemm_phase<pg8::EpiProjN, true>(ldsl, g, S, E); }
  grid.sync();
  PH(6) REP(6) {
    float lam;
    { const int lane = tid & 63; float a = p.in[11][lane] * p.in[12][lane], b = p.in[13][lane] * p.in[14][lane];
      for (int s = 1; s < 64; s <<= 1) { a += __shfl_xor(a, s); b += __shfl_xor(b, s); }
      lam = __expf(a) - __expf(b) + 0.2f; }
    float* tbl = (float*)(lds + 98304 + 2048);
    const int nu = (G % 8 == 0) ? 1536 : 0;
    for (int u = bid; u < 1536; u += G) {
      int b8, h, qb, seq;
      if (G == 256) {
        const int i = u >> 8, blk = u & 255, x = blk & 7, s = blk >> 3;
        if (i < 4) { const int bh = i * 8 + x; b8 = bh >> 3; h = bh & 7; qb = s; seq = 4096; }
        else { const int bh = (i - 4) * 16 + x * 2 + (s >> 4); b8 = 4 + (bh >> 3); h = bh & 7; qb = s & 15; seq = 2048; }
      } else {
        if (u < 1024) { b8 = u >> 8; h = (u >> 5) & 7; qb = u & 31; seq = 4096; }
        else { const int v = u - 1024; b8 = 4 + (v >> 7); h = (v >> 4) & 7; qb = v & 15; seq = 2048; }
      }
      (void)nu;
      const int tok0 = b8 < 4 ? b8 * 4096 : TP + (b8 - 4) * 2048;
      if (tid < 257) tbl[tid] = p.in[16][att::t5_bucket(tid - 128) * 8 + h] * LOG2E;
      const bf16_t* base = proj + (size_t)tok0 * LDP + h * 128;
      att::attn_unit((char*)lds, base + (size_t)(qb * 128) * LDP, base + 1024, base + 2048, mix + (size_t)(tok0 + qb * 128) * LDMIX + h * 128, seq, qb * 128, lam, p.in[15]);
    }
    for (int u = bid; u < 768; u += G) {
      const int pm = u >> 3, h = u & 7;
      const float lf = log2_gamma(p.in[17][h]), lb = log2_gamma(p.in[18][h]);
      const bf16_t* base = proj + (size_t)(pm * 256) * LDP + h * 128;
      att::ret_state_unit((char*)lds, base + 4096, base + 5120, st + (size_t)u * 32768, lf, lb);
    }
  }
  grid.sync();
  PH(7) {
    for (int it = bid * 512 + tid; it < 8 * 8 * 2 * 2048; it += G * 512) {
      const int e = it & 2047, dir = (it >> 11) & 1, h = (it >> 12) & 7, b8 = it >> 15;
      const int pm0 = b8 < 4 ? b8 * 16 : 64 + (b8 - 4) * 8, n = b8 < 4 ? 16 : 8;
      const float gch = __builtin_amdgcn_exp2f(256.f * log2_gamma(dir ? p.in[18][h] : p.in[17][h]));
      float run[8];
#pragma unroll
      for (int j = 0; j < 8; ++j) run[j] = 0.f;
      for (int c = 0; c < n; ++c) {
        const int pm = pm0 + (dir ? n - 1 - c : c);
        bf16_t* sp = st + ((size_t)(pm * 8 + h) * 2 + dir) * 16384 + e * 8;
        const u32x4 w = *(const u32x4*)sp; u32x4 o;
#pragma unroll
        for (int j = 0; j < 4; ++j) { o[j] = cvtpk(run[2 * j], run[2 * j + 1]);
          run[2 * j] = gch * run[2 * j] + __uint_as_float(w[j] << 16); run[2 * j + 1] = gch * run[2 * j + 1] + __uint_as_float(w[j] & 0xffff0000u); }
        *(u32x4*)sp = o;
      }
    }
  }
  grid.sync();
  PH(8) REP(8) {
    for (int u = bid; u < 768; u += G) {
      const int pm = u >> 3, h = u & 7;
      const float lf = log2_gamma(p.in[17][h]), lb = log2_gamma(p.in[18][h]);
      const bf16_t* base = proj + (size_t)(pm * 256) * LDP + h * 128;
      att::ret_out_unit((char*)lds, base + 3072, base + 4096, base + 5120, base + 6144, st + (size_t)u * 32768, mix + (size_t)(pm * 256) * LDMIX + 1024 + h * 128, lf, lb, p.in[19]);
    }
  }
  grid.sync();
  PH(9) { pg8::Gemm g{mix, wout, TALL, DM, DM}; pg8::StaticOrder S; S.init(TALL, DM, G, bid); pg8::EpiResidN<false> E{out, out + (size_t)TP * DM, out, mod + 5 * DM, a2buf, p.in[21], mod + 7 * DM, ssq2}; pg8::gemm_phase<pg8::EpiResidN<false>, true>(ldsl, g, S, E); }
  grid.sync();
  PH(11) REP(11) { pg8::Gemm g{a2buf, w13b, TALL, 2 * DFF, DM}; pg8::StaticOrder S; S.init(TALL, 2 * DFF, G, bid); pg8::EpiSwiGLUN E{act, ssq2, bias2}; pg8::gemm_phase<pg8::EpiSwiGLUN, true>(ldsl, g, S, E); }
  grid.sync();
  PH(12) { pg8::Gemm g{act, w2b, TALL, DM, DFF}; pg8::StaticOrder S; S.init(TALL, DM, G, bid); pg8::EpiResid E{out, out + (size_t)TP * DM, out, mod + 8 * DM, 0.5f}; pg8::gemm_phase<pg8::EpiResid, true>(ldsl, g, S, E); }
  grid.sync();
  PH(13) final_norm_phase(out, p.in[24]);
}

extern "C" void kernel_launch(void* const* d_in, const int* in_sizes, int n_in, void* d_out, int out_size, void* d_ws, size_t ws_size, hipStream_t stream) {
  static int grid_blocks = 0;
  if (grid_blocks == 0) {
    if (n_in != 25 || out_size != TALL * DM || ws_size < WS_END) { fprintf(stderr, "kernel_launch: unexpected shapes n_in %d out %d ws %zu (need %zu)\n", n_in, out_size, ws_size, (size_t)WS_END); grid_blocks = -1; return; }
    int dev = 0, cus = 0, per_cu = 0;
    (void)hipGetDevice(&dev);
    (void)hipDeviceGetAttribute(&cus, hipDeviceAttributeMultiprocessorCount, dev);
    if (hipFuncSetAttribute((const void*)fwd_mega, hipFuncAttributeMaxDynamicSharedMemorySize, LDS_BYTES) != hipSuccess) { fprintf(stderr, "kernel_launch: hipFuncSetAttribute failed\n"); grid_blocks = -1; return; }
    if (hipOccupancyMaxActiveBlocksPerMultiprocessor(&per_cu, (const void*)fwd_mega, 512, LDS_BYTES) != hipSuccess || per_cu < 1) { fprintf(stderr, "kernel_launch: occupancy query gave %d\n", per_cu); per_cu = 1; }
    (void)hipGetLastError();
    grid_blocks = cus * per_cu;
  }
  if (grid_blocks < 0) return;
  (void)hipMemsetAsync((char*)d_ws + WS_MOD, 0, ZERO_BYTES, stream);
  Params p{};
  for (int i = 0; i < 25; ++i) p.in[i] = (const float*)d_in[i];
  p.out = (float*)d_out; p.ws = (unsigned char*)d_ws;
  void* args[] = {&p};
  hipError_t e = hipLaunchCooperativeKernel((const void*)fwd_mega, dim3(grid_blocks), dim3(512), args, LDS_BYTES, stream);
  if (e != hipSuccess) fprintf(stderr, "kernel_launch: cooperative launch failed: %s (grid %d)\n", hipGetErrorString(e), grid_blocks);
}
```

```cpp
#include <hip/hip_runtime.h>
#include <hip/hip_cooperative_groups.h>
#include <cstdio>
#include <cstdint>
namespace cg = cooperative_groups;

#define DI __device__ __forceinline__
#define LAS __attribute__((address_space(3)))
typedef unsigned short bf16_t;
typedef short bf16x8 __attribute__((ext_vector_type(8)));
typedef short s16x4 __attribute__((ext_vector_type(4)));
typedef float f32x4 __attribute__((ext_vector_type(4)));
typedef float f32x16 __attribute__((ext_vector_type(16)));
typedef unsigned u32x4 __attribute__((ext_vector_type(4)));
typedef unsigned u32x2 __attribute__((ext_vector_type(2)));

constexpr int DM = 2048, DFF = 5632, NIN = 7168, TP = 16384, TALL = 24576, NMODW = 18432;
constexpr int LDP = NIN, LDMIX = DM;
constexpr float EPS = 1e-6f, LOG2E = 1.4426950408889634f;
constexpr size_t MiB = 1u << 20;
constexpr size_t WS_MOD = 0, MOD_BYTES = (size_t)8 * NMODW * 4;
constexpr size_t WS_ROPE = 1 * MiB, WS_W13A = 3 * MiB, WS_W2A = 47 * MiB, WS_WIN = 69 * MiB, WS_WOUT = 97 * MiB, WS_W13B = 105 * MiB, WS_W2B = 149 * MiB;
constexpr size_t WS_H = 171 * MiB, WS_PROJ = 267 * MiB, WS_ST = 603 * MiB, WS_BIASM = 651 * MiB, WS_BIAS2 = WS_BIASM + (size_t)8 * NIN * 4, WS_END = 652 * MiB;
constexpr size_t WS_SSQ1 = MOD_BYTES, WS_SSQ2 = WS_SSQ1 + (size_t)TALL * 4, ZERO_BYTES = WS_SSQ2 + (size_t)TALL * 4;
constexpr size_t WS_A2 = 531 * MiB;
constexpr int LDS_BYTES = 147456;

DI unsigned cvtpk(float lo, float hi) { unsigned r; asm volatile("v_cvt_pk_bf16_f32 %0, %1, %2" : "=v"(r) : "v"(lo), "v"(hi)); return r; }
DI bf16_t bf1(float x) { unsigned u = __float_as_uint(x); u += 0x7fffu + ((u >> 16) & 1u); return (bf16_t)(u >> 16); }
DI float bf2f(bf16_t b) { return __uint_as_float((unsigned)b << 16); }
DI float fsilu(float x) { return x * __builtin_amdgcn_rcpf(1.f + __builtin_amdgcn_exp2f(-x * LOG2E)); }
DI int row_b8(int row) { return row < TP ? (row >> 12) : 4 + ((row - TP) >> 11); }
DI int row_pos(int row) { return row < TP ? (row & 4095) : ((row - TP) & 2047); }

namespace pg8 {
constexpr int BM = 256, BK = 64, HALF = 128, HTB = HALF * BK * 2, STAGE_BYTES = 8 * HTB, NXCD = 8, WGM = 4;
DI int lds_byte(int r, int c) { const int st = (r >> 4) * 2 + (c >> 5), rr = r & 15, cc = c & 31, ob = rr * 64 + cc * 2; return st * 1024 + (ob ^ (((ob >> 9) & 1) << 5)); }
DI void stage_rc(int b, int& R, int& C) { const int st = b / 1024, sb = b % 1024, swz = sb ^ (((sb >> 9) & 1) << 5); R = (st >> 1) * 16 + swz / 64; C = (st & 1) * 32 + (swz % 64) / 2; }
DI int perm32(int rho) { const int n = rho >> 4, i = rho & 15; return 8 * (i >> 2) + 4 * n + (i & 3); }
struct Unit { int pm, pn; };
struct Gemm { const bf16_t* A; const bf16_t* Bt; int M, N, K; };
struct StaticOrder {
    int nM, nN, nwg, G, c;
    DI void init(int M, int N, int G_, int c_) { nM = M / BM; nN = N / BM; nwg = nM * nN; G = G_; c = c_; }
    DI bool next(int i, Unit& u) const {
        const long L = (long)i * G + c; if (L >= nwg) return false;
        int wgid = (int)L; { const int q = nwg / NXCD, r = nwg % NXCD, xcd = wgid % NXCD, off = wgid / NXCD; wgid = (xcd < r ? xcd * (q + 1) : r * (q + 1) + (xcd - r) * q) + off; }
        const int nig = WGM * nN, gid = wgid / nig, fm = gid * WGM, gsz = (nM - fm) < WGM ? (nM - fm) : WGM;
        u.pm = fm + ((wgid % nig) % gsz); u.pn = (wgid % nig) / gsz; return true;
    }
};
template <class Epi, bool ALIGN_EPI>
DI void gemm_phase(LAS unsigned char* lds, const Gemm g, const StaticOrder S, const Epi E) {
    int tid_ = threadIdx.x; asm volatile("" : "+v"(tid_));
    const int tid = tid_, wid = __builtin_amdgcn_readfirstlane(tid >> 6), lane = tid & 63, wr = wid >> 2, wc = wid & 3, fr = lane & 15, fq = lane >> 4;
    const int K = g.K, nt = K / BK;
    unsigned voffA[2], voffB[2];
#pragma unroll
    for (int i = 0; i < 2; ++i) { int R, C; stage_rc(tid * 16 + i * 8192, R, C); const int Rb = Epi::PERM ? ((R & ~31) + perm32(R & 31)) : R;
        voffA[i] = (unsigned)(R * K + C) * 2u; voffB[i] = (unsigned)(Rb * K + C) * 2u; }
    const size_t kstep = (size_t)(BK * 2);
    const size_t hstep = (size_t)HALF * K * 2;
    const size_t tstep = 2 * hstep;
    const unsigned ldsw = (unsigned)wid * 1024u;
    const int aoff = lds_byte(wr * 64 + fr, fq * 8), boff = lds_byte(wc * 32 + fr, fq * 8);
#define PG8_SA(b, h) (((b) * 2 + (h)) * HTB)
#define PG8_SB(b, h) ((4 + (b) * 2 + (h)) * HTB)
#define PG8_STAGE(bufoff, gbase, voff) do { _Pragma("unroll") for (int _i = 0; _i < 2; ++_i) \
        __builtin_amdgcn_global_load_lds((const unsigned*)((const char*)(gbase) + (voff)[_i]), (LAS unsigned*)(lds + (bufoff) + ldsw + _i * 8192), 16, 0, 0); } while (0)
#define PG8_LDA(dst, b, h) do { _Pragma("unroll") for (int m = 0; m < 4; ++m) _Pragma("unroll") for (int k = 0; k < 2; ++k) dst[m][k] = *(const LAS bf16x8*)(lds + PG8_SA(b, h) + aoff + m * 2048 + k * 1024); } while (0)
#define PG8_LDB(dst, b, h) do { _Pragma("unroll") for (int n = 0; n < 2; ++n) _Pragma("unroll") for (int k = 0; k < 2; ++k) dst[n][k] = *(const LAS bf16x8*)(lds + PG8_SB(b, h) + boff + n * 2048 + k * 1024); } while (0)
#define PG8_MMA(ai, bj, At, Bt) do { __builtin_amdgcn_s_setprio(1); _Pragma("unroll") for (int m = 0; m < 4; ++m) _Pragma("unroll") for (int n = 0; n < 2; ++n) _Pragma("unroll") for (int k = 0; k < 2; ++k) \
        acc[ai][bj][m][n] = __builtin_amdgcn_mfma_f32_16x16x32_bf16(Bt[n][k], At[m][k], acc[ai][bj][m][n], 0, 0, 0); __builtin_amdgcn_s_setprio(0); } while (0)
#define PG8_WAIT_V(n) asm volatile("s_waitcnt vmcnt(" #n ")" ::: "memory")
#define PG8_WAIT_L(n) asm volatile("s_waitcnt lgkmcnt(" #n ")" ::: "memory")
#define PG8_BAR __builtin_amdgcn_s_barrier()
#define PG8_SCHED __builtin_amdgcn_sched_barrier(0)
    Unit cur, nxt; int ui = 0;
    if (!S.next(0, cur)) return;
    f32x4 acc[2][2][4][2];
#pragma unroll
    for (int a = 0; a < 2; ++a)
#pragma unroll
        for (int b = 0; b < 2; ++b)
#pragma unroll
            for (int m = 0; m < 4; ++m)
#pragma unroll
                for (int n = 0; n < 2; ++n) acc[a][b][m][n] = (f32x4){0.f, 0.f, 0.f, 0.f};
    bf16x8 At[4][2], B0[2][2], B1[2][2];
    const char* cA = (const char*)g.A + (size_t)cur.pm * tstep; const char* cB = (const char*)g.Bt + (size_t)cur.pn * tstep;
    PG8_STAGE(PG8_SB(0, 0), cB, voffB); PG8_STAGE(PG8_SB(0, 1), cB + hstep, voffB); PG8_STAGE(PG8_SA(0, 0), cA, voffA); PG8_STAGE(PG8_SA(0, 1), cA + hstep, voffA);
    if (wr == 1) PG8_BAR;
    PG8_WAIT_V(2); PG8_BAR;
    PG8_STAGE(PG8_SB(1, 0), cB + kstep, voffB); PG8_STAGE(PG8_SA(1, 0), cA + kstep, voffA); PG8_STAGE(PG8_SB(1, 1), cB + hstep + kstep, voffB);
    PG8_WAIT_V(6); PG8_BAR;
    for (;;) {
        const bool has_next = S.next(ui + 1, nxt);
        const char* nA = has_next ? (const char*)g.A + (size_t)nxt.pm * tstep : cA; const char* nB = has_next ? (const char*)g.Bt + (size_t)nxt.pn * tstep : cB;
        for (int t = 0; t < nt; t += 2) {
            const bool last = (t == nt - 2);
            const char* a1 = cA + (size_t)(t + 1) * kstep;
            const char* a2 = last ? nA : cA + (size_t)(t + 2) * kstep; const char* b2 = last ? nB : cB + (size_t)(t + 2) * kstep;
            const char* a3 = a2 + kstep; const char* b3 = b2 + kstep;
            PG8_LDB(B0, 0, 0); PG8_LDB(B1, 0, 1); PG8_SCHED; PG8_LDA(At, 0, 0); PG8_STAGE(PG8_SA(1, 1), a1 + hstep, voffA);
            PG8_WAIT_V(8); PG8_WAIT_L(0); PG8_BAR; PG8_MMA(0, 0, At, B0); PG8_MMA(0, 1, At, B1); PG8_BAR; PG8_SCHED;
            PG8_LDA(At, 0, 1); PG8_STAGE(PG8_SB(0, 0), b2, voffB); PG8_STAGE(PG8_SB(0, 1), b2 + hstep, voffB); PG8_STAGE(PG8_SA(0, 0), a2, voffA);
            PG8_WAIT_V(8); PG8_WAIT_L(0); PG8_BAR; PG8_MMA(1, 0, At, B0); PG8_MMA(1, 1, At, B1); PG8_BAR; PG8_SCHED;
            PG8_LDB(B0, 1, 0); PG8_LDB(B1, 1, 1); PG8_SCHED; PG8_LDA(At, 1, 0); PG8_STAGE(PG8_SA(0, 1), a2 + hstep, voffA);
            PG8_WAIT_V(8); PG8_WAIT_L(0); PG8_BAR; PG8_MMA(0, 0, At, B0); PG8_MMA(0, 1, At, B1); PG8_BAR; PG8_SCHED;
            PG8_LDA(At, 1, 1); PG8_STAGE(PG8_SB(1, 0), b3, voffB); PG8_STAGE(PG8_SB(1, 1), b3 + hstep, voffB); PG8_STAGE(PG8_SA(1, 0), a3, voffA);
            PG8_WAIT_V(8); PG8_WAIT_L(0); PG8_BAR; PG8_MMA(1, 0, At, B0); PG8_MMA(1, 1, At, B1); PG8_BAR; PG8_SCHED;
        }
        if constexpr (ALIGN_EPI) { if (wr == 0) PG8_BAR; }
        { int fr_ = fr, fq_ = fq; asm volatile("" : "+v"(fr_), "+v"(fq_));
          E(acc, cur, wr, wc, fr_, fq_); }
        if (!has_next) break;
#pragma unroll
        for (int a = 0; a < 2; ++a)
#pragma unroll
            for (int b = 0; b < 2; ++b)
#pragma unroll
                for (int m = 0; m < 4; ++m)
#pragma unroll
                    for (int n = 0; n < 2; ++n) acc[a][b][m][n] = (f32x4){0.f, 0.f, 0.f, 0.f};
        cur = nxt; cA = nA; cB = nB; ++ui;
        if constexpr (ALIGN_EPI) { if (wr == 1) PG8_BAR; }
    }
    PG8_WAIT_V(0);
    if constexpr (!ALIGN_EPI) { if (wr == 0) PG8_BAR; }
    PG8_BAR;
#undef PG8_SA
#undef PG8_SB
#undef PG8_STAGE
#undef PG8_LDA
#undef PG8_LDB
#undef PG8_MMA
#undef PG8_WAIT_V
#undef PG8_WAIT_L
#undef PG8_BAR
#undef PG8_SCHED
}

struct EpiSwiGLU {
    static constexpr bool PERM = true;
    bf16_t* O;
    DI void operator()(const f32x4 (&acc)[2][2][4][2], const Unit& u, int wr, int wc, int fr, int fq) const {
        const int row0 = u.pm * BM + wr * 64 + fr, col0 = u.pn * 128 + wc * 32 + 8 * fq;
#pragma unroll
        for (int ai = 0; ai < 2; ++ai)
#pragma unroll
            for (int m = 0; m < 4; ++m) {
                bf16_t* rowp = O + (size_t)(row0 + ai * HALF + m * 16) * DFF + col0;
                const f32x4 g0 = acc[ai][0][m][0], g1 = acc[ai][0][m][1], u0 = acc[ai][1][m][0], u1 = acc[ai][1][m][1];
                float r[8];
#pragma unroll
                for (int j = 0; j < 4; ++j) { r[j] = fsilu(g0[j]) * u0[j]; r[4 + j] = fsilu(g1[j]) * u1[j]; }
                u32x4 w; w.x = cvtpk(r[0], r[1]); w.y = cvtpk(r[2], r[3]); w.z = cvtpk(r[4], r[5]); w.w = cvtpk(r[6], r[7]);
                *(u32x4*)rowp = w;
            }
    }
};
struct EpiResid {
    static constexpr bool PERM = false;
    const float* xa; const float* xb; float* out; const float* gate; float s;
    DI void operator()(const f32x4 (&acc)[2][2][4][2], const Unit& u, int wr, int wc, int fr, int fq) const {
        const int row0t = u.pm * BM; const int b8 = row_b8(row0t);
        const float* gp = gate + (size_t)b8 * NMODW; const int col0 = u.pn * BM + wc * 32 + 4 * fq;
        f32x4 gv[2][2];
#pragma unroll
        for (int bj = 0; bj < 2; ++bj)
#pragma unroll
            for (int n = 0; n < 2; ++n) gv[bj][n] = *(const f32x4*)(gp + col0 + bj * HALF + n * 16) * s;
#pragma unroll
        for (int ai = 0; ai < 2; ++ai)
#pragma unroll
            for (int m = 0; m < 4; ++m) {
                const int row = row0t + ai * HALF + wr * 64 + m * 16 + fr;
                const float* xin = row < TP ? xa + (size_t)row * DM : xb + (size_t)(row - TP) * DM;
                float* op = out + (size_t)row * DM;
#pragma unroll
                for (int bj = 0; bj < 2; ++bj)
#pragma unroll
                    for (int n = 0; n < 2; ++n) { const int c = col0 + bj * HALF + n * 16; const f32x4 xv = *(const f32x4*)(xin + c); *(f32x4*)(op + c) = xv + gv[bj][n] * acc[ai][bj][m][n]; }
            }
    }
};
struct EpiProj {
    static constexpr bool PERM = true;
    bf16_t* O; const float* rope;
    DI void operator()(const f32x4 (&acc)[2][2][4][2], const Unit& u, int wr, int wc, int fr, int fq) const {
        const int row0 = u.pm * BM + wr * 64 + fr, col0 = u.pn * BM + wc * 32 + 8 * fq;
        const int mode = (u.pn >= 12 && u.pn < 20) ? (u.pn >= 16 ? 2 : 1) : 0;
        if (mode == 0) {
#pragma unroll
            for (int ai = 0; ai < 2; ++ai)
#pragma unroll
                for (int m = 0; m < 4; ++m) { bf16_t* rowp = O + (size_t)(row0 + ai * HALF + m * 16) * NIN + col0;
#pragma unroll
                    for (int bj = 0; bj < 2; ++bj) { const f32x4 v0 = acc[ai][bj][m][0], v1 = acc[ai][bj][m][1];
                        u32x4 w; w.x = cvtpk(v0[0], v0[1]); w.y = cvtpk(v0[2], v0[3]); w.z = cvtpk(v1[0], v1[1]); w.w = cvtpk(v1[2], v1[3]);
                        *(u32x4*)(rowp + bj * HALF) = w; } }
        } else {
            const float ksc = mode == 2 ? 0.08838834764831845f : 1.f;
#pragma unroll
            for (int ai = 0; ai < 2; ++ai)
#pragma unroll
                for (int m = 0; m < 4; ++m) { const int row = row0 + ai * HALF + m * 16; bf16_t* rowp = O + (size_t)row * NIN + col0;
                    const float* rp = rope + ((size_t)row_pos(row) * 64 + 16 * wc + 4 * fq) * 2;
                    const f32x4 cs0 = *(const f32x4*)rp, cs1 = *(const f32x4*)(rp + 4);
                    const float cc[4] = {cs0[0] * ksc, cs0[2] * ksc, cs1[0] * ksc, cs1[2] * ksc}, ss[4] = {cs0[1] * ksc, cs0[3] * ksc, cs1[1] * ksc, cs1[3] * ksc};
#pragma unroll
                    for (int bj = 0; bj < 2; ++bj) { const f32x4 x1 = acc[ai][bj][m][0], x2 = acc[ai][bj][m][1]; float o1[4], o2[4];
#pragma unroll
                        for (int j = 0; j < 4; ++j) { o1[j] = x1[j] * cc[j] - x2[j] * ss[j]; o2[j] = x1[j] * ss[j] + x2[j] * cc[j]; }
                        u32x4 w; w.x = cvtpk(o1[0], o1[1]); w.y = cvtpk(o1[2], o1[3]); w.z = cvtpk(o2[0], o2[1]); w.w = cvtpk(o2[2], o2[3]);
                        *(u32x4*)(rowp + bj * HALF) = w; } }
        }
    }
};

template <bool HALFS> struct EpiResidN {
    static constexpr bool PERM = false; static constexpr float s = HALFS ? 0.5f : 1.0f;
    const float* xa; const float* xb; float* out; const float* gate; bf16_t* A2; const float* gn; const float* scn; float* ssq;
    DI void operator()(const f32x4 (&acc)[2][2][4][2], const Unit& u, int wr, int wc, int fr, int fq) const {
        const int row0t = u.pm * BM; const int b8 = row_b8(row0t);
        const float* gp = gate + (size_t)b8 * NMODW; const float* sp = scn + (size_t)b8 * NMODW; const int col0 = u.pn * BM + wc * 32 + 4 * fq;
        f32x4 gv[2][2], gs[2][2];
#pragma unroll
        for (int bj = 0; bj < 2; ++bj)
#pragma unroll
            for (int n = 0; n < 2; ++n) { const int c = col0 + bj * HALF + n * 16; gv[bj][n] = *(const f32x4*)(gp + c) * s; gs[bj][n] = *(const f32x4*)(gn + c) * (*(const f32x4*)(sp + c) + 1.f); }
#pragma unroll
        for (int ai = 0; ai < 2; ++ai)
#pragma unroll
            for (int m = 0; m < 4; ++m) {
                const int row = row0t + ai * HALF + wr * 64 + m * 16 + fr;
                const float* xin = row < TP ? xa + (size_t)row * DM : xb + (size_t)(row - TP) * DM;
                float* op = out + (size_t)row * DM; bf16_t* ap = A2 + (size_t)row * DM; float sq = 0.f;
#pragma unroll
                for (int bj = 0; bj < 2; ++bj)
#pragma unroll
                    for (int n = 0; n < 2; ++n) { const int c = col0 + bj * HALF + n * 16; const f32x4 xv = *(const f32x4*)(xin + c); const f32x4 xn = xv + gv[bj][n] * acc[ai][bj][m][n];
                        *(f32x4*)(op + c) = xn; sq += xn[0] * xn[0] + xn[1] * xn[1] + xn[2] * xn[2] + xn[3] * xn[3];
                        const f32x4 y = xn * gs[bj][n]; u32x2 w; w.x = cvtpk(y[0], y[1]); w.y = cvtpk(y[2], y[3]); *(u32x2*)(ap + c) = w; }
                sq += __shfl_xor(sq, 16); sq += __shfl_xor(sq, 32);
                if (fq == 0) atomicAdd(ssq + row, sq);
            }
    }
};
struct EpiSwiGLUN {
    static constexpr bool PERM = true;
    bf16_t* O; const float* ssq; const float* bias;
    DI void operator()(const f32x4 (&acc)[2][2][4][2], const Unit& u, int wr, int wc, int fr, int fq) const {
        const int row0 = u.pm * BM + wr * 64 + fr, col0 = u.pn * 128 + wc * 32 + 8 * fq;
        const float* bp = bias + (size_t)row_b8(u.pm * BM) * (2 * DFF) + u.pn * BM + wc * 32 + 8 * fq;
        const f32x4 bg0 = *(const f32x4*)bp, bg1 = *(const f32x4*)(bp + 4), bu0 = *(const f32x4*)(bp + HALF), bu1 = *(const f32x4*)(bp + HALF + 4);
#pragma unroll
        for (int ai = 0; ai < 2; ++ai)
#pragma unroll
            for (int m = 0; m < 4; ++m) {
                const int row = row0 + ai * HALF + m * 16;
                const float rstd = __builtin_amdgcn_rsqf(ssq[row] * (1.f / DM) + EPS);
                bf16_t* rowp = O + (size_t)row * DFF + col0;
                const f32x4 g0 = acc[ai][0][m][0] * rstd + bg0, g1 = acc[ai][0][m][1] * rstd + bg1, u0 = acc[ai][1][m][0] * rstd + bu0, u1 = acc[ai][1][m][1] * rstd + bu1;
                float r[8];
#pragma unroll
                for (int j = 0; j < 4; ++j) { r[j] = fsilu(g0[j]) * u0[j]; r[4 + j] = fsilu(g1[j]) * u1[j]; }
                u32x4 w; w.x = cvtpk(r[0], r[1]); w.y = cvtpk(r[2], r[3]); w.z = cvtpk(r[4], r[5]); w.w = cvtpk(r[6], r[7]);
                *(u32x4*)rowp = w;
            }
    }
};
struct EpiProjN {
    static constexpr bool PERM = true;
    bf16_t* O; const float* rope; const float* ssq; const float* bias;
    DI void operator()(const f32x4 (&acc)[2][2][4][2], const Unit& u, int wr, int wc, int fr, int fq) const {
        const int row0 = u.pm * BM + wr * 64 + fr, col0 = u.pn * BM + wc * 32 + 8 * fq;
        const int mode = (u.pn >= 12 && u.pn < 20) ? (u.pn >= 16 ? 2 : 1) : 0;
        const float* bp = bias + (size_t)row_b8(u.pm * BM) * NIN + col0;
        f32x4 bv[2][2];
#pragma unroll
        for (int bj = 0; bj < 2; ++bj)
#pragma unroll
            for (int n = 0; n < 2; ++n) bv[bj][n] = *(const f32x4*)(bp + bj * HALF + 4 * n);
        const float ksc = mode == 2 ? 0.08838834764831845f : 1.f;
#pragma unroll
        for (int ai = 0; ai < 2; ++ai)
#pragma unroll
            for (int m = 0; m < 4; ++m) { const int row = row0 + ai * HALF + m * 16; bf16_t* rowp = O + (size_t)row * NIN + col0;
                const float rstd = __builtin_amdgcn_rsqf(ssq[row] * (1.f / DM) + EPS);
                float cc[4] = {1.f, 1.f, 1.f, 1.f}, ss[4] = {0.f, 0.f, 0.f, 0.f};
                if (mode != 0) { const float* rp = rope + ((size_t)row_pos(row) * 64 + 16 * wc + 4 * fq) * 2;
                    const f32x4 cs0 = *(const f32x4*)rp, cs1 = *(const f32x4*)(rp + 4);
                    cc[0] = cs0[0] * ksc; cc[1] = cs0[2] * ksc; cc[2] = cs1[0] * ksc; cc[3] = cs1[2] * ksc; ss[0] = cs0[1] * ksc; ss[1] = cs0[3] * ksc; ss[2] = cs1[1] * ksc; ss[3] = cs1[3] * ksc; }
#pragma unroll
                for (int bj = 0; bj < 2; ++bj) { const f32x4 x1 = acc[ai][bj][m][0] * rstd + bv[bj][0], x2 = acc[ai][bj][m][1] * rstd + bv[bj][1]; float o1[4], o2[4];
#pragma unroll
                    for (int j = 0; j < 4; ++j) { o1[j] = mode ? x1[j] * cc[j] - x2[j] * ss[j] : x1[j]; o2[j] = mode ? x1[j] * ss[j] + x2[j] * cc[j] : x2[j]; }
                    u32x4 w; w.x = cvtpk(o1[0], o1[1]); w.y = cvtpk(o1[2], o1[3]); w.z = cvtpk(o2[0], o2[1]); w.w = cvtpk(o2[2], o2[3]);
                    *(u32x4*)(rowp + bj * HALF) = w; } }
    }
};
}

namespace att {
constexpr int KVBLK = 64;
constexpr int SHM_V = KVBLK * 128 * 2, SHM_K = KVBLK * 128 * 2;
#define KSWZ(row, colB) ((row) * 256 + ((colB) ^ (((row) & 7) << 4)))
#define SBAR() __builtin_amdgcn_sched_barrier(0)
DI int crow(int r, int hi) { return (r & 3) + 8 * (r >> 2) + 4 * hi; }
DI int v_st(int k, int c) { const int kk = (k & ~0xC) | ((k & 4) << 1) | ((k & 8) >> 1); return ((kk >> 3) * 4 + (c >> 5)) * 512 + ((kk & 7) * 32 + (c & 31)) * 2; }
DI int v_rd_base(int lane) { return ((lane & 3) << 3) | (((lane >> 2) & 3) << 6) | (((lane >> 4) & 1) << 5) | (((lane >> 5) & 1) << 8); }
constexpr int v_rd_off(int d0, int ks, int half) { return d0 * 512 + ks * 4096 + half * 2048; }
template <int OFF> DI s16x4 tr_read(int vb) { s16x4 r; asm volatile("ds_read_b64_tr_b16 %0, %1 offset:%2" : "=&v"(r) : "v"(vb), "i"(OFF) : "memory"); return r; }
#define PKLH(L, H) (bf16x8){L[0], L[1], L[2], L[3], H[0], H[1], H[2], H[3]}
template <int D0> DI void pv_one(f32x16& od, int vb, bf16x8 pa0, bf16x8 pa1, bf16x8 pa2, bf16x8 pa3) {
  const s16x4 l0 = tr_read<v_rd_off(D0, 0, 0)>(vb), h0 = tr_read<v_rd_off(D0, 0, 1)>(vb), l1 = tr_read<v_rd_off(D0, 1, 0)>(vb), h1 = tr_read<v_rd_off(D0, 1, 1)>(vb);
  const s16x4 l2 = tr_read<v_rd_off(D0, 2, 0)>(vb), h2 = tr_read<v_rd_off(D0, 2, 1)>(vb), l3 = tr_read<v_rd_off(D0, 3, 0)>(vb), h3 = tr_read<v_rd_off(D0, 3, 1)>(vb);
  asm volatile("s_waitcnt lgkmcnt(0)" ::: "memory"); SBAR();
  od = __builtin_amdgcn_mfma_f32_32x32x16_bf16(pa0, PKLH(l0, h0), od, 0, 0, 0);
  od = __builtin_amdgcn_mfma_f32_32x32x16_bf16(pa1, PKLH(l1, h1), od, 0, 0, 0);
  od = __builtin_amdgcn_mfma_f32_32x32x16_bf16(pa2, PKLH(l2, h2), od, 0, 0, 0);
  od = __builtin_amdgcn_mfma_f32_32x32x16_bf16(pa3, PKLH(l3, h3), od, 0, 0, 0);
}
DI void pv_d0(f32x16* o, int vb, bf16x8 pa0, bf16x8 pa1, bf16x8 pa2, bf16x8 pa3) {
  pv_one<0>(o[0], vb, pa0, pa1, pa2, pa3); pv_one<1>(o[1], vb, pa0, pa1, pa2, pa3); pv_one<2>(o[2], vb, pa0, pa1, pa2, pa3); pv_one<3>(o[3], vb, pa0, pa1, pa2, pa3);
}
#define PK4(P, BASE, OUT) do { unsigned a0 = cvtpk(P[BASE + 0], P[BASE + 1]), a1 = cvtpk(P[BASE + 2], P[BASE + 3]);   \
    unsigned b0 = cvtpk(P[BASE + 4], P[BASE + 5]), b1 = cvtpk(P[BASE + 6], P[BASE + 7]);                              \
    auto r0 = __builtin_amdgcn_permlane32_swap(a0, b0, false, false); auto r1 = __builtin_amdgcn_permlane32_swap(a1, b1, false, false); \
    u32x4 w = {r0[0], r1[0], r0[1], r1[1]}; OUT = *reinterpret_cast<bf16x8*>(&w); } while (0)

constexpr float C_QK = 0.125f * LOG2E;
constexpr float THRL = 8.f * LOG2E;
typedef float f32x2v __attribute__((ext_vector_type(2)));
DI void partialSM(f32x16& p0, f32x16& p1, float& m_reg, float& alpha, int relbase, int r32, int hi, const float* tbl) {
  float mn;
  const bool far = (relbase - 31 >= 91 || relbase + 63 <= -91);
  float cb = 0.f;
  if (far) { cb = relbase > 0 ? tbl[256] : tbl[0]; }
  else {
    int base = relbase - r32 + 128; asm volatile("" : "+v"(base));
    for (int r = 0; r < 16; ++r) { int i0 = base + crow(r, hi); int i1 = i0 + 32; i0 = min(max(i0, 0), 256); i1 = min(max(i1, 0), 256);
      p0[r] = fmaf(p0[r], C_QK, tbl[i0]); p1[r] = fmaf(p1[r], C_QK, tbl[i1]); if ((r & 3) == 3) SBAR(); }
  }
  float pmax = fmaxf(p0[0], p0[1]);
  for (int r = 2; r < 16; r += 2) pmax = fmaxf(fmaxf(pmax, p0[r]), p0[r + 1]);
  for (int r = 0; r < 16; r += 2) pmax = fmaxf(fmaxf(pmax, p1[r]), p1[r + 1]);
  { auto rr = __builtin_amdgcn_permlane32_swap(__float_as_uint(pmax), __float_as_uint(pmax), false, false);
    pmax = fmaxf(__uint_as_float(rr[0]), __uint_as_float(rr[1])); }
  const float tmax = far ? fmaf(pmax, C_QK, cb) : pmax;
  if (__builtin_expect(__all(tmax - m_reg <= THRL), 1)) { mn = m_reg; alpha = 1.f; }
  else { mn = fmaxf(m_reg, tmax); alpha = __builtin_amdgcn_exp2f(m_reg - mn); m_reg = mn; }
  SBAR();
  const float scl = far ? C_QK : 1.f, off = far ? cb - mn : -mn;
  const f32x2v sc2 = {scl, scl}, of2 = {off, off};
  for (int r = 0; r < 16; r += 2) { f32x2v v = {p0[r], p0[r + 1]}; v = v * sc2 + of2; p0[r] = v.x; p0[r + 1] = v.y; }
  for (int r = 0; r < 16; r += 2) { f32x2v v = {p1[r], p1[r + 1]}; v = v * sc2 + of2; p1[r] = v.x; p1[r + 1] = v.y; }
  SBAR();
  for (int r = 0; r < 16; ++r) p0[r] = __builtin_amdgcn_exp2f(p0[r]);
}
DI void finishSM(f32x16& p0, f32x16& p1, float alpha, float& l_reg, bf16x8& pa0, bf16x8& pa1, bf16x8& pa2, bf16x8& pa3) {
  for (int r = 0; r < 16; ++r) p1[r] = __builtin_amdgcn_exp2f(p1[r]);
  f32x2v s2 = {0.f, 0.f};
  for (int r = 0; r < 16; r += 2) { const f32x2v a = {p0[r], p0[r + 1]}, b = {p1[r], p1[r + 1]}; s2 = s2 + a; s2 = s2 + b; }
  float ps = s2.x + s2.y;
  { auto rr = __builtin_amdgcn_permlane32_swap(__float_as_uint(ps), __float_as_uint(ps), false, false);
    ps = __uint_as_float(rr[0]) + __uint_as_float(rr[1]); }
  l_reg = l_reg * alpha + ps;
  PK4(p0, 0, pa0); PK4(p0, 8, pa1); PK4(p1, 0, pa2); PK4(p1, 8, pa3);
}
template <int ND0> DI void qkt(f32x16& p0, f32x16& p1, const bf16_t* Ks, const bf16x8* qr, int r32, int hi, int colb0) {
  p0 = f32x16{}; p1 = f32x16{};
#pragma unroll
  for (int d0 = 0; d0 < ND0; ++d0) { int cb = colb0 + (d0 * 16 + hi * 8) * 2;
    bf16x8 b0 = *reinterpret_cast<const bf16x8*>((const char*)Ks + KSWZ(r32, cb));
    bf16x8 b1 = *reinterpret_cast<const bf16x8*>((const char*)Ks + KSWZ(32 + r32, cb));
    p0 = __builtin_amdgcn_mfma_f32_32x32x16_bf16(b0, qr[d0], p0, 0, 0, 0);
    p1 = __builtin_amdgcn_mfma_f32_32x32x16_bf16(b1, qr[d0], p1, 0, 0, 0); }
}
DI int t5_bucket(int rel) {
  const int n = rel < 0 ? -rel : rel;
  int bk = n < 8 ? n : (n < 12 ? 8 : n < 16 ? 9 : n < 23 ? 10 : n < 32 ? 11 : n < 46 ? 12 : n < 64 ? 13 : n < 91 ? 14 : 15);
  return bk + (rel > 0 ? 16 : 0);
}

DI void attn_unit(char* lds, const bf16_t* __restrict__ Qb, const bf16_t* __restrict__ Kh, const bf16_t* __restrict__ Vh, bf16_t* __restrict__ Ob,
                  int seq, int q0, float lam, const float* __restrict__ hg) {
  int tid_ = threadIdx.x; asm volatile("" : "+v"(tid_));
  const int tid = tid_, wid = __builtin_amdgcn_readfirstlane(tid >> 6), lane = tid & 63, r32 = lane & 31, hi = lane >> 5, qg = wid & 3, sm = wid >> 2;
  float* ws = (float*)(lds + 98304) + wid * 64; float* li_l = ws; float* al_l = ws + 32;
  const float* tbl = (const float*)(lds + 98304 + 2048);
  float* xb = (float*)lds;
  float m_reg = -1e30f, l_reg = 0; f32x16 o[4] = {}; bf16x8 qr[4];
  const bf16_t* Qw = Qb + (long)(qg * 32 + r32) * LDP + sm * 64 + hi * 8;
#pragma unroll
  for (int d0 = 0; d0 < 4; ++d0) qr[d0] = *reinterpret_cast<const bf16x8*>(Qw + d0 * 16);
  const int colb0 = sm * 128;
  const int qw0 = q0 + qg * 32;
  const int sr = tid >> 4, sc = (tid & 15) * 8, vst0 = v_st(sr, sc), vst1 = v_st(32 + sr, sc);
  const int vb0 = (int)(uintptr_t)lds + v_rd_base(lane);
  constexpr int SDEPTH = 2;
  struct { bf16x8 vs0, vs1, ks0, ks1; } sr_[SDEPTH];
#define SLOAD(i, k0) do { sr_[i].vs0 = *(const bf16x8*)(&Vh[(long)((k0) + sr) * LDP + sc]); sr_[i].vs1 = *(const bf16x8*)(&Vh[(long)((k0) + 32 + sr) * LDP + sc]); \
    sr_[i].ks0 = *(const bf16x8*)(&Kh[(long)((k0) + sr) * LDP + sc]); sr_[i].ks1 = *(const bf16x8*)(&Kh[(long)((k0) + 32 + sr) * LDP + sc]); } while (0)
#define SWRITE(boff, i) do { char* vb_ = lds + (boff); char* kb_ = vb_ + 16384; *(bf16x8*)(vb_ + vst0) = sr_[i].vs0;          \
    *(bf16x8*)(vb_ + vst1) = sr_[i].vs1; int kc = sc * 2;               \
    *(bf16x8*)(kb_ + KSWZ(sr, kc)) = sr_[i].ks0;                       \
    *(bf16x8*)(kb_ + KSWZ(32 + sr, kc)) = sr_[i].ks1; } while (0)
#define SWAIT() do { if constexpr (SDEPTH == 2) asm volatile("s_waitcnt vmcnt(4)" ::: "memory"); else asm volatile("s_waitcnt vmcnt(0)" ::: "memory"); } while (0)
#define RESC(a) do { if (__any((a) < 1.f)) { if (hi == 0) al_l[r32] = (a); asm volatile("s_waitcnt lgkmcnt(0)" ::: "memory"); \
    for (int d = 0; d < 4; ++d) for (int r = 0; r < 16; ++r) o[d][r] *= al_l[crow(r, hi)]; } } while (0)
  f32x16 pA0, pA1, pB0, pB1; float alA, alB; bf16x8 pa0, pa1, pa2, pa3; const int NT = seq / KVBLK;
  constexpr int SE = 0, SO = SDEPTH - 1;
  static_assert(SDEPTH == 2, "3-buffer ring below is written for SDEPTH 2");
#define KB(off) ((const bf16_t*)(lds + (off) + 16384))
  int bP = 0, bC = 32768, bN = 65536;
  SLOAD(SE, 0); asm volatile("s_waitcnt vmcnt(0)" ::: "memory"); SWRITE(0, SE); __syncthreads();
  qkt<4>(pA0, pA1, KB(0), qr, r32, hi, colb0); partialSM(pA0, pA1, m_reg, alA, 0 - qw0, r32, hi, tbl);
  SLOAD(SO, KVBLK); if (2 < NT) SLOAD(SE, 2 * KVBLK);
  SWAIT(); SWRITE(32768, SO); __syncthreads();
  for (int j = 1; j + 1 < NT; j += 2) {
    SBAR(); qkt<4>(pB0, pB1, KB(bC), qr, r32, hi, colb0);
    finishSM(pA0, pA1, alA, l_reg, pa0, pa1, pa2, pa3); SBAR();
    SLOAD(SO, (j + 2) * KVBLK); SBAR();
    pv_d0(o, vb0 + bP, pa0, pa1, pa2, pa3); partialSM(pB0, pB1, m_reg, alB, j * KVBLK - qw0, r32, hi, tbl);
    SWAIT(); SWRITE(bN, SE);
    RESC(alB); __syncthreads();
    SBAR(); qkt<4>(pA0, pA1, KB(bN), qr, r32, hi, colb0);
    finishSM(pB0, pB1, alB, l_reg, pa0, pa1, pa2, pa3); SBAR();
    if (j + 3 < NT) SLOAD(SE, (j + 3) * KVBLK); SBAR();
    pv_d0(o, vb0 + bC, pa0, pa1, pa2, pa3); partialSM(pA0, pA1, m_reg, alA, (j + 1) * KVBLK - qw0, r32, hi, tbl);
    SWAIT(); SWRITE(bP, SO);
    RESC(alA); __syncthreads();
    { const int t_ = bP; bP = bN; bN = bC; bC = t_; }
  }
  SBAR(); qkt<4>(pB0, pB1, KB(bC), qr, r32, hi, colb0);
  finishSM(pA0, pA1, alA, l_reg, pa0, pa1, pa2, pa3); SBAR();
  pv_d0(o, vb0 + bP, pa0, pa1, pa2, pa3); partialSM(pB0, pB1, m_reg, alB, (NT - 1) * KVBLK - qw0, r32, hi, tbl);
  RESC(alB);
  finishSM(pB0, pB1, alB, l_reg, pa0, pa1, pa2, pa3); SBAR();
  pv_d0(o, vb0 + bC, pa0, pa1, pa2, pa3);
#undef KB
  if (hi == 0) li_l[r32] = l_reg; asm volatile("s_waitcnt lgkmcnt(0)" ::: "memory");
  float rli[16];
  const float sgn = sm ? -lam : 1.f;
#pragma unroll
  for (int r = 0; r < 16; ++r) rli[r] = __builtin_amdgcn_rcpf(li_l[crow(r, hi)]) * sgn;
  __syncthreads();
  if (sm == 1) {
#pragma unroll
    for (int d0 = 0; d0 < 4; ++d0)
#pragma unroll
      for (int r = 0; r < 16; ++r) xb[((qg * 4 + d0) * 16 + r) * 64 + lane] = o[d0][r] * rli[r];
  }
  __syncthreads();
  if (sm == 0) {
    float g4[4];
#pragma unroll
    for (int d0 = 0; d0 < 4; ++d0) g4[d0] = hg[d0 * 32 + r32] * 0.8f;
    char* myl = lds + 104448 + qg * 8704;
#pragma unroll
    for (int r = 0; r < 16; ++r) {
      float v[4]; float ss = 0.f;
#pragma unroll
      for (int d0 = 0; d0 < 4; ++d0) { v[d0] = o[d0][r] * rli[r] + xb[((qg * 4 + d0) * 16 + r) * 64 + lane]; ss += v[d0] * v[d0]; }
      ss += __shfl_xor(ss, 1); ss += __shfl_xor(ss, 2); ss += __shfl_xor(ss, 4); ss += __shfl_xor(ss, 8); ss += __shfl_xor(ss, 16);
      const float rs = __builtin_amdgcn_rsqf(ss * (1.f / 128.f) + EPS);
      char* lp = myl + (((r & 3) + 8 * (r >> 2)) + 4 * hi) * 272 + r32 * 2;
#pragma unroll
      for (int d0 = 0; d0 < 4; ++d0) *(bf16_t*)(lp + d0 * 64) = bf1(v[d0] * rs * g4[d0]);
    }
    asm volatile("s_waitcnt lgkmcnt(0)" ::: "memory");
    int rb = qg * 32; asm volatile("" : "+v"(rb));
#pragma unroll
    for (int i = 0; i < 8; ++i) { const int c = lane + 64 * i, row = c >> 4, c8 = (c & 15) * 8;
      *(u32x4*)(Ob + (long)(rb + row) * LDMIX + c8) = *(const u32x4*)(myl + row * 272 + c8 * 2); }
  }
  __syncthreads();
#undef SLOAD
#undef SWRITE
#undef SWAIT
#undef RESC
}

DI bf16x8 scale8(bf16x8 v, float s) {
  u32x4 w = *reinterpret_cast<u32x4*>(&v); u32x4 o;
#pragma unroll
  for (int i = 0; i < 4; ++i) { const float lo = __uint_as_float(w[i] << 16), hi = __uint_as_float(w[i] & 0xffff0000u); o[i] = cvtpk(lo * s, hi * s); }
  return *reinterpret_cast<bf16x8*>(&o);
}

DI void ret_state_unit(char* lds, const bf16_t* __restrict__ Kh, const bf16_t* __restrict__ Vh, bf16_t* __restrict__ St  , float lf, float lb) {
  int tid_ = threadIdx.x; asm volatile("" : "+v"(tid_));
  const int tid = tid_, wid = tid >> 6, lane = tid & 63, r32 = lane & 31, hi = lane >> 5, dir = wid >> 2, a0 = wid & 3;
  char* Ki = lds; char* Vi = lds + SHM_V;
  const int sr = tid >> 4, sc = (tid & 15) * 8, vst0 = v_st(sr, sc), vst1 = v_st(32 + sr, sc);
  const int kb = (int)(uintptr_t)Ki + v_rd_base(lane) + a0 * 512, vb = (int)(uintptr_t)Vi + v_rd_base(lane);
  const float lg = dir ? lb : lf;
  f32x16 acc[4] = {};
  bf16x8 k0v, k1v, v0v, v1v;
#define R1_LOAD(k0) do { k0v = *(const bf16x8*)(&Kh[(long)((k0) + sr) * LDP + sc]); k1v = *(const bf16x8*)(&Kh[(long)((k0) + 32 + sr) * LDP + sc]); \
    v0v = *(const bf16x8*)(&Vh[(long)((k0) + sr) * LDP + sc]); v1v = *(const bf16x8*)(&Vh[(long)((k0) + 32 + sr) * LDP + sc]); } while (0)
  R1_LOAD(0);
  for (int t = 0; t < 4; ++t) {
    __syncthreads();
    *(bf16x8*)(Ki + vst0) = k0v; *(bf16x8*)(Ki + vst1) = k1v; *(bf16x8*)(Vi + vst0) = v0v; *(bf16x8*)(Vi + vst1) = v1v;
    __syncthreads();
    if (t < 3) R1_LOAD((t + 1) * 64);
#define RSTEP(KS) do { \
    const s16x4 la = tr_read<v_rd_off(0, KS, 0)>(kb), ha = tr_read<v_rd_off(0, KS, 1)>(kb); \
    const s16x4 l0 = tr_read<v_rd_off(0, KS, 0)>(vb), h0 = tr_read<v_rd_off(0, KS, 1)>(vb), l1 = tr_read<v_rd_off(1, KS, 0)>(vb), h1 = tr_read<v_rd_off(1, KS, 1)>(vb); \
    const s16x4 l2 = tr_read<v_rd_off(2, KS, 0)>(vb), h2 = tr_read<v_rd_off(2, KS, 1)>(vb), l3 = tr_read<v_rd_off(3, KS, 0)>(vb), h3 = tr_read<v_rd_off(3, KS, 1)>(vb); \
    asm volatile("s_waitcnt lgkmcnt(0)" ::: "memory"); SBAR(); \
    bf16x8 A = PKLH(la, ha); \
    { const int tok0 = t * 64 + 16 * KS + 8 * hi; u32x4 w = *reinterpret_cast<u32x4*>(&A); u32x4 ow; \
      _Pragma("unroll") for (int i = 0; i < 4; ++i) { const int ta = tok0 + 2 * i, tb2 = ta + 1; \
        const float za = __builtin_amdgcn_exp2f(lg * (float)(dir ? ta : 255 - ta)), zb = __builtin_amdgcn_exp2f(lg * (float)(dir ? tb2 : 255 - tb2)); \
        ow[i] = cvtpk(__uint_as_float(w[i] << 16) * za, __uint_as_float(w[i] & 0xffff0000u) * zb); } \
      A = *reinterpret_cast<bf16x8*>(&ow); } \
    acc[0] = __builtin_amdgcn_mfma_f32_32x32x16_bf16(A, PKLH(l0, h0), acc[0], 0, 0, 0); \
    acc[1] = __builtin_amdgcn_mfma_f32_32x32x16_bf16(A, PKLH(l1, h1), acc[1], 0, 0, 0); \
    acc[2] = __builtin_amdgcn_mfma_f32_32x32x16_bf16(A, PKLH(l2, h2), acc[2], 0, 0, 0); \
    acc[3] = __builtin_amdgcn_mfma_f32_32x32x16_bf16(A, PKLH(l3, h3), acc[3], 0, 0, 0); } while (0)
    RSTEP(0); RSTEP(1); RSTEP(2); RSTEP(3);
#undef RSTEP
  }
#undef R1_LOAD
  bf16_t* sp = St + (size_t)dir * 16384;
#pragma unroll
  for (int d0 = 0; d0 < 4; ++d0)
#pragma unroll
    for (int r = 0; r < 16; ++r) sp[(32 * a0 + crow(r, hi)) * 128 + 32 * d0 + r32] = bf1(acc[d0][r]);
  __syncthreads();
}

DI void ret_out_unit(char* lds, const bf16_t* __restrict__ Qb, const bf16_t* __restrict__ Kh, const bf16_t* __restrict__ Vh, const bf16_t* __restrict__ Gb,
                     const bf16_t* __restrict__ St  , bf16_t* __restrict__ Ob, float lf, float lb, const float* __restrict__ hg) {
  int tid_ = threadIdx.x; asm volatile("" : "+v"(tid_));
  const int tid = tid_, wid = tid >> 6, lane = tid & 63, r32 = lane & 31, hi = lane >> 5;
  char* Vi = lds; char* Ki = lds + 2 * SHM_V;
  const int sr = tid >> 4, sc = (tid & 15) * 8, vst0 = v_st(sr, sc), vst1 = v_st(32 + sr, sc);
  const int vb = (int)(uintptr_t)Vi + v_rd_base(lane);
  bf16x8 qr[8]; f32x16 o[4] = {};
  const int nl = wid * 32 + r32;
  const bf16_t* Qw = Qb + (long)nl * LDP + hi * 8;
#pragma unroll
  for (int d0 = 0; d0 < 8; ++d0) qr[d0] = *reinterpret_cast<const bf16x8*>(Qw + d0 * 16);
  bf16x8 k0v, k1v, v0v, v1v;
#define R3_LOADKV(k0) do { k0v = *(const bf16x8*)(&Kh[(long)((k0) + sr) * LDP + sc]); k1v = *(const bf16x8*)(&Kh[(long)((k0) + 32 + sr) * LDP + sc]); \
    v0v = *(const bf16x8*)(&Vh[(long)((k0) + sr) * LDP + sc]); v1v = *(const bf16x8*)(&Vh[(long)((k0) + 32 + sr) * LDP + sc]); } while (0)
#define R3_LOADR(dir, half) do { const bf16_t* Rp_ = St + (size_t)(dir) * 16384; v0v = *(const bf16x8*)(&Rp_[((half) * 64 + sr) * 128 + sc]); v1v = *(const bf16x8*)(&Rp_[((half) * 64 + 32 + sr) * 128 + sc]); } while (0)
  R3_LOADKV(0);
  for (int t = 0; t < 4; ++t) {
    __syncthreads();
    { const int kc = sc * 2;
      *(bf16x8*)(Ki + KSWZ(sr, kc)) = k0v; *(bf16x8*)(Ki + KSWZ(32 + sr, kc)) = k1v; *(bf16x8*)(Vi + vst0) = v0v; *(bf16x8*)(Vi + vst1) = v1v; }
    __syncthreads();
    if (t < 3) R3_LOADKV((t + 1) * 64); else R3_LOADR(0, 0);
    f32x16 p0, p1; qkt<8>(p0, p1, (const bf16_t*)Ki, qr, r32, hi, 0);
#pragma unroll
    for (int r = 0; r < 16; ++r) {
      const int d0_ = nl - (t * 64 + crow(r, hi)), d1_ = d0_ - 32;
      p0[r] *= __builtin_amdgcn_exp2f(d0_ >= 0 ? lf * (float)d0_ : lb * (float)(-d0_));
      p1[r] *= __builtin_amdgcn_exp2f(d1_ >= 0 ? lf * (float)d1_ : lb * (float)(-d1_));
      if ((r & 3) == 3) SBAR();
    }
    bf16x8 pa0, pa1, pa2, pa3;
    PK4(p0, 0, pa0); PK4(p0, 8, pa1); PK4(p1, 0, pa2); PK4(p1, 8, pa3);
    pv_d0(o, vb, pa0, pa1, pa2, pa3);
  }
#pragma unroll
  for (int dir = 0; dir < 2; ++dir) {
    const float xi = __builtin_amdgcn_exp2f(dir ? lb * (float)(256 - nl) : lf * (float)(nl + 1));
#pragma unroll
    for (int half = 0; half < 2; ++half) {
      __syncthreads();
      *(bf16x8*)(Vi + vst0) = v0v; *(bf16x8*)(Vi + vst1) = v1v;
      __syncthreads();
      if (dir * 2 + half < 3) R3_LOADR((dir * 2 + half + 1) >> 1, (dir * 2 + half + 1) & 1);
      pv_d0(o, vb, scale8(qr[half * 4 + 0], xi), scale8(qr[half * 4 + 1], xi), scale8(qr[half * 4 + 2], xi), scale8(qr[half * 4 + 3], xi));
    }
  }
#undef R3_LOADKV
#undef R3_LOADR
  float g4[4];
#pragma unroll
  for (int d0 = 0; d0 < 4; ++d0) g4[d0] = hg[d0 * 32 + r32];
  __syncthreads();
  char* myl = lds + wid * 8704;
  u32x4 gt[8];
  int rb = wid * 32; asm volatile("" : "+v"(rb));
#pragma unroll
  for (int i = 0; i < 8; ++i) { const int c = lane + 64 * i; gt[i] = *(const u32x4*)(Gb + (long)(rb + (c >> 4)) * LDP + (c & 15) * 8); }
#pragma unroll
  for (int r = 0; r < 16; ++r) {
    float ss = 0.f;
#pragma unroll
    for (int d0 = 0; d0 < 4; ++d0) ss += o[d0][r] * o[d0][r];
    ss += __shfl_xor(ss, 1); ss += __shfl_xor(ss, 2); ss += __shfl_xor(ss, 4); ss += __shfl_xor(ss, 8); ss += __shfl_xor(ss, 16);
    const float rs = __builtin_amdgcn_rsqf(ss * (1.f / 128.f) + EPS);
    char* lp = myl + (((r & 3) + 8 * (r >> 2)) + 4 * hi) * 272 + r32 * 2;
#pragma unroll
    for (int d0 = 0; d0 < 4; ++d0) *(bf16_t*)(lp + d0 * 64) = bf1(o[d0][r] * rs * g4[d0]);
  }
  asm volatile("s_waitcnt lgkmcnt(0)" ::: "memory");
#pragma unroll
  for (int i = 0; i < 8; ++i) { const int c = lane + 64 * i, row = c >> 4, c8 = (c & 15) * 8;
    const u32x4 v = *(const u32x4*)(myl + row * 272 + c8 * 2); u32x4 w;
#pragma unroll
    for (int j = 0; j < 4; ++j) { const float glo = __uint_as_float(gt[i][j] << 16), ghi = __uint_as_float(gt[i][j] & 0xffff0000u);
      w[j] = cvtpk(__uint_as_float(v[j] << 16) * fsilu(glo), __uint_as_float(v[j] & 0xffff0000u) * fsilu(ghi)); }
    *(u32x4*)(Ob + (long)(rb + row) * LDMIX + c8) = w; }
  __syncthreads();
}
}

struct Params { const float* in[25]; float* out; unsigned char* ws; };

DI int srcmap(int mode, int np) {
  if (mode == 1) { const int pn = np >> 8, bj = (np >> 7) & 1, i = np & 127; return bj * DFF + pn * 128 + i; }
  if (mode == 2 && np >= 3072 && np < 5120) { const int p = np & 127, wc = p >> 5, fq = (p >> 3) & 3, n = (p >> 2) & 1, j = p & 3; return (np & ~127) + 64 * n + 16 * wc + 4 * fq + j; }
  return np;
}
DI void convert_tile(const float* __restrict__ W, bf16_t* __restrict__ Bt, int K, int N, int mode, int tile, float* tl) {
  const int ntn = N >> 6, kt = tile / ntn, nt = tile - kt * ntn, k0 = kt * 64, n0 = nt * 64, tid = threadIdx.x;
  { const int kl = tid >> 3, c8 = (tid & 7) * 8;
#pragma unroll
    for (int q = 0; q < 2; ++q) { const int src = srcmap(mode, n0 + c8 + 4 * q); const f32x4 v = *(const f32x4*)(W + (size_t)(k0 + kl) * N + src);
      float* d = tl + kl * 65 + c8 + 4 * q; d[0] = v[0]; d[1] = v[1]; d[2] = v[2]; d[3] = v[3]; } }
  __syncthreads();
  { const int nl = tid >> 3, kc = (tid & 7) * 8; float r[8];
#pragma unroll
    for (int i = 0; i < 8; ++i) r[i] = tl[(kc + i) * 65 + nl];
    u32x4 w; w.x = cvtpk(r[0], r[1]); w.y = cvtpk(r[2], r[3]); w.z = cvtpk(r[4], r[5]); w.w = cvtpk(r[6], r[7]);
    *(u32x4*)(Bt + (size_t)(n0 + nl) * K + k0 + kc) = w; }
  __syncthreads();
}
DI void mod_item(const Params& p, int item, float* red, float* mod) {
  const int tid = threadIdx.x, wid = tid >> 6, lane = tid & 63;
  const int cgp = item % 72, ks = item / 72, col = cgp * 256 + lane * 4, k0 = ks * 256 + wid * 32;
  const float* aw = p.in[4];
  f32x4 acc[8];
#pragma unroll
  for (int b = 0; b < 8; ++b) acc[b] = (f32x4){0.f, 0.f, 0.f, 0.f};
#pragma unroll 16
  for (int kk = 0; kk < 32; ++kk) { const int k = k0 + kk; const f32x4 w = *(const f32x4*)(aw + (size_t)k * NMODW + col);
#pragma unroll
    for (int b = 0; b < 8; ++b) { const float c = b < 4 ? p.in[2][b * DM + k] : p.in[3][(b - 4) * DM + k]; acc[b] += w * fsilu(c); } }
#pragma unroll
  for (int b = 0; b < 8; ++b) *(f32x4*)(red + ((wid * 8 + b) * 256) + lane * 4) = acc[b];
  __syncthreads();
  { const int o = tid * 4, b = o >> 8, c = o & 255; f32x4 s = (f32x4){0.f, 0.f, 0.f, 0.f};
#pragma unroll
    for (int w = 0; w < 8; ++w) s += *(const f32x4*)(red + ((w * 8 + b) * 256) + c);
    if (ks == 0) s += *(const f32x4*)(p.in[5] + cgp * 256 + c);
    float* mp = mod + (size_t)b * NMODW + cgp * 256 + c;
    atomicAdd(mp + 0, s[0]); atomicAdd(mp + 1, s[1]); atomicAdd(mp + 2, s[2]); atomicAdd(mp + 3, s[3]); }
  __syncthreads();
}
DI void norm_mod_phase(const float* xa, const float* xb, const float* __restrict__ g, const float* __restrict__ mod, int shi, int sci, bf16_t* __restrict__ h) {
  int t_ = threadIdx.x; asm volatile("" : "+v"(t_));
  const int wid = t_ >> 6, lane = t_ & 63;
  for (int row = blockIdx.x * 8 + wid; row < TALL; row += gridDim.x * 8) {
    const float* xr = row < TP ? xa + (size_t)row * DM : xb + (size_t)(row - TP) * DM;
    const float* mp = mod + (size_t)row_b8(row) * NMODW;
    f32x4 v[8]; float ss = 0.f;
#pragma unroll
    for (int i = 0; i < 8; ++i) { v[i] = *(const f32x4*)(xr + i * 256 + lane * 4); ss += v[i][0] * v[i][0] + v[i][1] * v[i][1] + v[i][2] * v[i][2] + v[i][3] * v[i][3]; }
    ss += __shfl_xor(ss, 1); ss += __shfl_xor(ss, 2); ss += __shfl_xor(ss, 4); ss += __shfl_xor(ss, 8); ss += __shfl_xor(ss, 16); ss += __shfl_xor(ss, 32);
    const float rstd = __builtin_amdgcn_rsqf(ss * (1.f / DM) + EPS);
#pragma unroll
    for (int i = 0; i < 8; ++i) { const int c = i * 256 + lane * 4;
      const f32x4 gg = *(const f32x4*)(g + c), sc = *(const f32x4*)(mp + sci * DM + c), sh = *(const f32x4*)(mp + shi * DM + c);
      const f32x4 y = v[i] * rstd * gg * (sc + 1.f) + sh;
      u32x2 w; w.x = cvtpk(y[0], y[1]); w.y = cvtpk(y[2], y[3]); *(u32x2*)(h + (size_t)row * DM + c) = w; }
  }
}
DI void bias_phase(const float* __restrict__ sh, const bf16_t* __restrict__ Wt, int N, float* __restrict__ bias, float* lsh) {
  int t_ = threadIdx.x; asm volatile("" : "+v"(t_));
  const int tid = t_, wid = tid >> 6, lane = tid & 63;
  __syncthreads();
  for (int i = tid; i < 8 * DM / 4; i += 512) { const int b = i >> 9, c4 = (i & 511) * 4; *(f32x4*)(lsh + b * DM + c4) = *(const f32x4*)(sh + (size_t)b * NMODW + c4); }
  __syncthreads();
  for (int col = blockIdx.x * 8 + wid; col < N; col += gridDim.x * 8) {
    const bf16_t* wrow = Wt + (size_t)col * DM;
    float a[8];
#pragma unroll
    for (int b = 0; b < 8; ++b) a[b] = 0.f;
#pragma unroll 1
    for (int i = 0; i < 4; ++i) { const int k = i * 512 + lane * 8; const u32x4 w = *(const u32x4*)(wrow + k); float wf[8];
#pragma unroll
      for (int j = 0; j < 4; ++j) { wf[2 * j] = __uint_as_float(w[j] << 16); wf[2 * j + 1] = __uint_as_float(w[j] & 0xffff0000u); }
#pragma unroll
      for (int b = 0; b < 8; ++b) { const f32x4 s0 = *(const f32x4*)(lsh + b * DM + k), s1 = *(const f32x4*)(lsh + b * DM + k + 4);
        a[b] += wf[0] * s0[0] + wf[1] * s0[1] + wf[2] * s0[2] + wf[3] * s0[3] + wf[4] * s1[0] + wf[5] * s1[1] + wf[6] * s1[2] + wf[7] * s1[3]; } }
#pragma unroll
    for (int b = 0; b < 8; ++b) { float v = a[b]; v += __shfl_xor(v, 1); v += __shfl_xor(v, 2); v += __shfl_xor(v, 4); v += __shfl_xor(v, 8); v += __shfl_xor(v, 16); v += __shfl_xor(v, 32);
      if (lane == 0) bias[(size_t)b * N + col] = v; }
  }
  __syncthreads();
}
DI void final_norm_phase(float* out, const float* __restrict__ g) {
  int t_ = threadIdx.x; asm volatile("" : "+v"(t_));
  const int wid = t_ >> 6, lane = t_ & 63;
  for (int row = blockIdx.x * 8 + wid; row < TALL; row += gridDim.x * 8) {
    float* xr = out + (size_t)row * DM;
    f32x4 v[8]; float ss = 0.f;
#pragma unroll
    for (int i = 0; i < 8; ++i) { v[i] = *(const f32x4*)(xr + i * 256 + lane * 4); ss += v[i][0] * v[i][0] + v[i][1] * v[i][1] + v[i][2] * v[i][2] + v[i][3] * v[i][3]; }
    ss += __shfl_xor(ss, 1); ss += __shfl_xor(ss, 2); ss += __shfl_xor(ss, 4); ss += __shfl_xor(ss, 8); ss += __shfl_xor(ss, 16); ss += __shfl_xor(ss, 32);
    const float rstd = __builtin_amdgcn_rsqf(ss * (1.f / DM) + EPS);
#pragma unroll
    for (int i = 0; i < 8; ++i) { const int c = i * 256 + lane * 4; *(f32x4*)(xr + c) = v[i] * rstd * *(const f32x4*)(g + c); }
  }
}
DI float log2_gamma(float x) {
  const float u = __expf(-x);
  float l;
  if (u < 0.05f) l = u * (1.f - u * (0.5f - u * (1.f / 3.f - u * (0.25f - u * (0.2f - u * (1.f / 6.f))))));
  else l = __logf(1.f + u);
  return -l * LOG2E;
}

#ifndef PHMASK
#define PHMASK 0xFFFF
#endif
#define PH(k) if constexpr ((PHMASK >> (k)) & 1)
#ifndef DBLMASK
#define DBLMASK 0
#endif
#define REP(k) for (int rep_ = 0; rep_ < (((DBLMASK) >> (k)) & 1) + 1; ++rep_)
__global__ void __launch_bounds__(512, 2) fwd_mega(Params p) {
  extern __shared__ __attribute__((aligned(16))) unsigned char lds[];
  cg::grid_group grid = cg::this_grid();
  const int tid = threadIdx.x, G = gridDim.x, bid = blockIdx.x;
  unsigned char* ws = p.ws;
  float* mod = (float*)(ws + WS_MOD); float* rope = (float*)(ws + WS_ROPE);
  bf16_t* w13a = (bf16_t*)(ws + WS_W13A); bf16_t* w2a = (bf16_t*)(ws + WS_W2A); bf16_t* win = (bf16_t*)(ws + WS_WIN); bf16_t* wout = (bf16_t*)(ws + WS_WOUT);
  bf16_t* w13b = (bf16_t*)(ws + WS_W13B); bf16_t* w2b = (bf16_t*)(ws + WS_W2B);
  bf16_t* hbuf = (bf16_t*)(ws + WS_H); bf16_t* proj = (bf16_t*)(ws + WS_PROJ); bf16_t* act = proj; bf16_t* mix = hbuf; bf16_t* st = (bf16_t*)(ws + WS_ST);
  float* out = p.out;
  float* ssq1 = (float*)(ws + WS_SSQ1); float* ssq2 = (float*)(ws + WS_SSQ2); float* biasM = (float*)(ws + WS_BIASM); float* bias2 = (float*)(ws + WS_BIAS2); bf16_t* a2buf = (bf16_t*)(ws + WS_A2);
  LAS unsigned char* ldsl = (LAS unsigned char*)lds;

  PH(0) {
    for (int it = bid; it < 576; it += G) mod_item(p, it, (float*)lds, mod);
    REP(0) for (int it = bid; it < 21504; it += G) {
      const float* W; bf16_t* Bt; int K, N, mode, tile = it;
      if (tile < 5632) { W = p.in[7]; Bt = w13a; K = DM; N = 2 * DFF; mode = 1; }
      else if ((tile -= 5632) < 2816) { W = p.in[8]; Bt = w2a; K = DFF; N = DM; mode = 0; }
      else if ((tile -= 2816) < 3584) { W = p.in[10]; Bt = win; K = DM; N = NIN; mode = 2; }
      else if ((tile -= 3584) < 1024) { W = p.in[20]; Bt = wout; K = DM; N = DM; mode = 0; }
      else if ((tile -= 1024) < 5632) { W = p.in[22]; Bt = w13b; K = DM; N = 2 * DFF; mode = 1; }
      else { tile -= 5632; W = p.in[23]; Bt = w2b; K = DFF; N = DM; mode = 0; }
      convert_tile(W, Bt, K, N, mode, tile, (float*)lds);
    }
    for (int e = bid * 512 + tid; e < 4096 * 64; e += G * 512) {
      const int pos = e >> 6, i = e & 63;
      const float inv = __builtin_amdgcn_exp2f(-(float)i * (13.287712379549449f / 64.f));
      const float ang = (float)pos * inv;
      double rev = (double)ang * 0.15915494309189535; rev -= __builtin_rint(rev);
      const float fr = (float)rev;
      rope[2 * e] = __builtin_amdgcn_cosf(fr); rope[2 * e + 1] = __builtin_amdgcn_sinf(fr);
    }
  }
  grid.sync();
  PH(1) REP(1) { norm_mod_phase(p.in[0], p.in[1], p.in[6], mod, 0, 1, hbuf);
    bias_phase(mod + 3 * DM, win, NIN, biasM, (float*)lds); bias_phase(mod + 6 * DM, w13b, 2 * DFF, bias2, (float*)lds); }
  grid.sync();
  PH(2) REP(2) { pg8::Gemm g{hbuf, w13a, TALL, 2 * DFF, DM}; pg8::StaticOrder S; S.init(TALL, 2 * DFF, G, bid); pg8::EpiSwiGLU E{act}; pg8::gemm_phase<pg8::EpiSwiGLU, true>(ldsl, g, S, E); }
  grid.sync();
  PH(3) REP(3) { pg8::Gemm g{act, w2a, TALL, DM, DFF}; pg8::StaticOrder S; S.init(TALL, DM, G, bid); pg8::EpiResidN<true> E{p.in[0], p.in[1], out, mod + 2 * DM, hbuf, p.in[9], mod + 4 * DM, ssq1}; pg8::gemm_phase<pg8::EpiResidN<true>, true>(ldsl, g, S, E); }
  grid.sync();
  PH(5) REP(5) { pg8::Gemm g{hbuf, win, TALL, NIN, DM}; pg8::StaticOrder S; S.init(TALL, NIN, G, bid); pg8::EpiProjN E{proj, rope, ssq1, biasM}; pg8::gemm_phase<pg8::EpiProjN, true>(ldsl, g, S, E); }
  grid.sync();
  PH(6) REP(6) {
    float lam;
    { const int lane = tid & 63; float a = p.in[11][lane] * p.in[12][lane], b = p.in[13][lane] * p.in[14][lane];
      for (int s = 1; s < 64; s <<= 1) { a += __shfl_xor(a, s); b += __shfl_xor(b, s); }
      lam = __expf(a) - __expf(b) + 0.2f; }
    float* tbl = (float*)(lds + 98304 + 2048);
    const int nu = (G % 8 == 0) ? 1536 : 0;
    REP(14) for (int u = bid; u < 1536; u += G) {
      int b8, h, qb, seq;
      if (G == 256) {
        const int i = u >> 8, blk = u & 255, x = blk & 7, s = blk >> 3;
        if (i < 4) { const int bh = i * 8 + x; b8 = bh >> 3; h = bh & 7; qb = s; seq = 4096; }
        else { const int bh = (i - 4) * 16 + x * 2 + (s >> 4); b8 = 4 + (bh >> 3); h = bh & 7; qb = s & 15; seq = 2048; }
      } else {
        if (u < 1024) { b8 = u >> 8; h = (u >> 5) & 7; qb = u & 31; seq = 4096; }
        else { const int v = u - 1024; b8 = 4 + (v >> 7); h = (v >> 4) & 7; qb = v & 15; seq = 2048; }
      }
      (void)nu;
      const int tok0 = b8 < 4 ? b8 * 4096 : TP + (b8 - 4) * 2048;
      if (tid < 257) tbl[tid] = p.in[16][att::t5_bucket(tid - 128) * 8 + h] * LOG2E;
      const bf16_t* base = proj + (size_t)tok0 * LDP + h * 128;
      att::attn_unit((char*)lds, base + (size_t)(qb * 128) * LDP, base + 1024, base + 2048, mix + (size_t)(tok0 + qb * 128) * LDMIX + h * 128, seq, qb * 128, lam, p.in[15]);
    }
    REP(15) for (int u = bid; u < 768; u += G) {
      const int pm = u >> 3, h = u & 7;
      const float lf = log2_gamma(p.in[17][h]), lb = log2_gamma(p.in[18][h]);
      const bf16_t* base = proj + (size_t)(pm * 256) * LDP + h * 128;
      att::ret_state_unit((char*)lds, base + 4096, base + 5120, st + (size_t)u * 32768, lf, lb);
    }
  }
  grid.sync();
  PH(7) {
    for (int it = bid * 512 + tid; it < 8 * 8 * 2 * 2048; it += G * 512) {
      const int e = it & 2047, dir = (it >> 11) & 1, h = (it >> 12) & 7, b8 = it >> 15;
      const int pm0 = b8 < 4 ? b8 * 16 : 64 + (b8 - 4) * 8, n = b8 < 4 ? 16 : 8;
      const float gch = __builtin_amdgcn_exp2f(256.f * log2_gamma(dir ? p.in[18][h] : p.in[17][h]));
      float run[8];
#pragma unroll
      for (int j = 0; j < 8; ++j) run[j] = 0.f;
      for (int c = 0; c < n; ++c) {
        const int pm = pm0 + (dir ? n - 1 - c : c);
        bf16_t* sp = st + ((size_t)(pm * 8 + h) * 2 + dir) * 16384 + e * 8;
        const u32x4 w = *(const u32x4*)sp; u32x4 o;
#pragma unroll
        for (int j = 0; j < 4; ++j) { o[j] = cvtpk(run[2 * j], run[2 * j + 1]);
          run[2 * j] = gch * run[2 * j] + __uint_as_float(w[j] << 16); run[2 * j + 1] = gch * run[2 * j + 1] + __uint_as_float(w[j] & 0xffff0000u); }
        *(u32x4*)sp = o;
      }
    }
  }
  grid.sync();
  PH(8) REP(8) {
    for (int u = bid; u < 768; u += G) {
      const int pm = u >> 3, h = u & 7;
      const float lf = log2_gamma(p.in[17][h]), lb = log2_gamma(p.in[18][h]);
      const bf16_t* base = proj + (size_t)(pm * 256) * LDP + h * 128;
      att::ret_out_unit((char*)lds, base + 3072, base + 4096, base + 5120, base + 6144, st + (size_t)u * 32768, mix + (size_t)(pm * 256) * LDMIX + 1024 + h * 128, lf, lb, p.in[19]);
    }
  }
  grid.sync();
  PH(9) { pg8::Gemm g{mix, wout, TALL, DM, DM}; pg8::StaticOrder S; S.init(TALL, DM, G, bid); pg8::EpiResidN<false> E{out, out + (size_t)TP * DM, out, mod + 5 * DM, a2buf, p.in[21], mod + 7 * DM, ssq2}; pg8::gemm_phase<pg8::EpiResidN<false>, true>(ldsl, g, S, E); }
  grid.sync();
  PH(11) REP(11) { pg8::Gemm g{a2buf, w13b, TALL, 2 * DFF, DM}; pg8::StaticOrder S; S.init(TALL, 2 * DFF, G, bid); pg8::EpiSwiGLUN E{act, ssq2, bias2}; pg8::gemm_phase<pg8::EpiSwiGLUN, true>(ldsl, g, S, E); }
  grid.sync();
  PH(12) { pg8::Gemm g{act, w2b, TALL, DM, DFF}; pg8::StaticOrder S; S.init(TALL, DM, G, bid); pg8::EpiResid E{out, out + (size_t)TP * DM, out, mod + 8 * DM, 0.5f}; pg8::gemm_phase<pg8::EpiResid, true>(ldsl, g, S, E); }
  grid.sync();
  PH(13) final_norm_phase(out, p.in[24]);
}

extern "C" void kernel_launch(void* const* d_in, const int* in_sizes, int n_in, void* d_out, int out_size, void* d_ws, size_t ws_size, hipStream_t stream) {
  static int grid_blocks = 0;
  if (grid_blocks == 0) {
    if (n_in != 25 || out_size != TALL * DM || ws_size < WS_END) { fprintf(stderr, "kernel_launch: unexpected shapes n_in %d out %d ws %zu (need %zu)\n", n_in, out_size, ws_size, (size_t)WS_END); grid_blocks = -1; return; }
    int dev = 0, cus = 0, per_cu = 0;
    (void)hipGetDevice(&dev);
    (void)hipDeviceGetAttribute(&cus, hipDeviceAttributeMultiprocessorCount, dev);
    if (hipFuncSetAttribute((const void*)fwd_mega, hipFuncAttributeMaxDynamicSharedMemorySize, LDS_BYTES) != hipSuccess) { fprintf(stderr, "kernel_launch: hipFuncSetAttribute failed\n"); grid_blocks = -1; return; }
    if (hipOccupancyMaxActiveBlocksPerMultiprocessor(&per_cu, (const void*)fwd_mega, 512, LDS_BYTES) != hipSuccess || per_cu < 1) { fprintf(stderr, "kernel_launch: occupancy query gave %d\n", per_cu); per_cu = 1; }
    (void)hipGetLastError();
    grid_blocks = cus * per_cu;
  }
  if (grid_blocks < 0) return;
  (void)hipMemsetAsync((char*)d_ws + WS_MOD, 0, ZERO_BYTES, stream);
  Params p{};
  for (int i = 0; i < 25; ++i) p.in[i] = (const float*)d_in[i];
  p.out = (float*)d_out; p.ws = (unsigned char*)d_ws;
  void* args[] = {&p};
  hipError_t e = hipLaunchCooperativeKernel((const void*)fwd_mega, dim3(grid_blocks), dim3(512), args, LDS_BYTES, stream);
  if (e != hipSuccess) fprintf(stderr, "kernel_launch: cooperative launch failed: %s (grid %d)\n", hipGetErrorString(e), grid_blocks);
}
```
